# Optimizing an MI355X kernel written in HIP

```python
import math
import jax
import jax.numpy as jnp
from jax import lax
import numpy as np

D_MODEL = 2048
BATCH = 2
SEQ = 16384
DEPTH = 4

GRID_W = 64
CTX_LEN = 256
MIX_WIDTH = D_MODEL
ATTN_WIDTH = MIX_WIDTH // 2
HYENA_WIDTH = MIX_WIDTH // 4
POOL_WIDTH = MIX_WIDTH - ATTN_WIDTH - HYENA_WIDTH
HEAD_DIM = 128
N_HEADS = ATTN_WIDTH // HEAD_DIM
N_KV_HEADS = 2
KV_GROUP = N_HEADS // N_KV_HEADS
KV_WIDTH = N_KV_HEADS * HEAD_DIM
WINDOW = 128
BLOCK = 128
ROPE_BASE = 10000.0
HYENA_ORDER = 2
HYENA_SHORT = 3
HYENA_EMB_DIM = 33
HYENA_FILTER_HIDDEN = 64
HYENA_FAST_DECAY_PCT = 0.3
HYENA_SLOW_DECAY_PCT = 1.5
HYENA_DECAY_TARGET = 1e-2
POOL_WINDOWS = (2, 4, 8, 16)
POOL_GROUP = POOL_WIDTH // len(POOL_WINDOWS)
MLP_HIDDEN = 4 * D_MODEL
N_MOD = 6
EPS = 1e-6
NEG_INF = -1e30

Q_END = ATTN_WIDTH
K_END = Q_END + KV_WIDTH
V_END = K_END + KV_WIDTH
HY_END = V_END + (HYENA_ORDER + 1) * HYENA_WIDTH
IN_WIDTH = HY_END + POOL_WIDTH

kernel_name = "hybrid_dit_swa_hyena_pool_trunk"


def rmsnorm(x, g):
    xf = x.astype(jnp.float32)
    y = xf * lax.rsqrt(jnp.mean(xf * xf, axis=-1, keepdims=True) + EPS)
    return (y * g.astype(jnp.float32)).astype(x.dtype)


def modulate(h, shift, scale):
    return h * (1 + scale) + shift


def axial_rope(x, row, col):
    half = HEAD_DIM // 2
    quarter = half // 2
    inv_freq = ROPE_BASE ** (-jnp.arange(quarter, dtype=jnp.float32) / quarter)

    def rotate(xh, pos):
        ang = pos.astype(jnp.float32)[:, None] * inv_freq[None, :]
        cos = jnp.cos(ang)[None, :, None, :].astype(xh.dtype)
        sin = jnp.sin(ang)[None, :, None, :].astype(xh.dtype)
        x1, x2 = xh[..., :quarter], xh[..., quarter:]
        return jnp.concatenate([x1 * cos - x2 * sin, x2 * cos + x1 * sin], axis=-1)

    return jnp.concatenate([rotate(x[..., :half], row), rotate(x[..., half:], col)], axis=-1)


def sink_softmax(s, sink):
    m = jnp.maximum(jnp.max(s, axis=-1, keepdims=True), sink)
    p = jnp.exp(s - m)
    return p / (jnp.sum(p, axis=-1, keepdims=True) + jnp.exp(sink - m))


def context_attention(q, k, v, sink):
    b, n = q.shape[:2]
    qg = q.reshape(b, n, N_KV_HEADS, KV_GROUP, HEAD_DIM)
    s = jnp.einsum('bqkgd,bskd->bkgqs', qg, k).astype(jnp.float32) * HEAD_DIM ** -0.5
    p = sink_softmax(s, sink.astype(jnp.float32).reshape(1, N_KV_HEADS, KV_GROUP, 1, 1))
    o = jnp.einsum('bkgqs,bskd->bqkgd', p.astype(v.dtype), v)
    return o.reshape(b, n, ATTN_WIDTH)


def window_attention(q, k, v, k_ctx, v_ctx, sink):
    b, n = q.shape[:2]
    nb = n // BLOCK
    qb = q.reshape(b, nb, BLOCK, N_KV_HEADS, KV_GROUP, HEAD_DIM)

    def band(t):
        tp = jnp.pad(t, ((0, 0), (BLOCK, BLOCK), (0, 0), (0, 0))).reshape(b, nb + 2, BLOCK, N_KV_HEADS, HEAD_DIM)
        return jnp.concatenate([tp[:, :-2], tp[:, 1:-1], tp[:, 2:]], axis=2)

    kb, vb = band(k), band(v)
    scale = HEAD_DIM ** -0.5
    s_loc = jnp.einsum('bnqkgd,bnskd->bnkgqs', qb, kb).astype(jnp.float32) * scale
    blk = jnp.arange(nb)[:, None, None]
    qi = jnp.arange(BLOCK)[None, :, None]
    sj = jnp.arange(3 * BLOCK)[None, None, :]
    kpos = (blk - 1) * BLOCK + sj
    valid = (jnp.abs(sj - BLOCK - qi) <= WINDOW) & (kpos >= 0) & (kpos < n)
    s_loc = jnp.where(valid[None, :, None, None], s_loc, NEG_INF)
    s_ctx = jnp.einsum('bnqkgd,bskd->bnkgqs', qb, k_ctx).astype(jnp.float32) * scale
    p = sink_softmax(jnp.concatenate([s_loc, s_ctx], axis=-1),
                     sink.astype(jnp.float32).reshape(1, 1, N_KV_HEADS, KV_GROUP, 1, 1))
    p = p.astype(v.dtype)
    o = (jnp.einsum('bnkgqs,bnskd->bnqkgd', p[..., :3 * BLOCK], vb)
         + jnp.einsum('bnkgqs,bskd->bnqkgd', p[..., 3 * BLOCK:], v_ctx))
    return o.reshape(b, n, ATTN_WIDTH)


def short_conv(u, w, bias):
    n = u.shape[1]
    up = jnp.pad(u, ((0, 0), (1, 1), (0, 0)))
    return up[:, :n] * w[0] + up[:, 1:n + 1] * w[1] + up[:, 2:] * w[2] + bias


def hyena_filter(n, w1, b1, f1, w2, b2, f2, w3):
    t = jnp.linspace(0.0, 1.0, n, dtype=jnp.float32)[:, None]
    bands = (HYENA_EMB_DIM - 1) // 2
    omega = 2.0 * math.pi * jnp.arange(n, dtype=jnp.float32)[:, None] / n
    f = jnp.linspace(1e-4, bands - 1, bands, dtype=jnp.float32)[None, :]
    feats = jnp.concatenate([t, jnp.cos(f * omega), -jnp.sin(f * omega)], axis=-1).astype(w1.dtype)
    h = jnp.sin(f1 * (feats @ w1 + b1))
    h = jnp.sin(f2 * (h @ w2 + b2))
    h = (h @ w3).astype(jnp.float32).reshape(n, 2, HYENA_WIDTH)
    max_decay = math.log(HYENA_DECAY_TARGET) / HYENA_FAST_DECAY_PCT
    min_decay = math.log(HYENA_DECAY_TARGET) / HYENA_SLOW_DECAY_PCT
    deltas = jnp.abs(jnp.linspace(min_decay, max_decay, HYENA_WIDTH, dtype=jnp.float32))
    h = h * jnp.exp(-t[:, :, None] * deltas)
    h = h / jnp.sum(jnp.abs(h), axis=(0, 1), keepdims=True)
    h_fwd, h_bwd = h[:, 0], h[:, 1]
    k = jnp.concatenate([h_fwd, jnp.zeros((1, HYENA_WIDTH), jnp.float32), h_bwd[:0:-1]], axis=0)
    return k.at[0].add(h_bwd[0])


def fft_long_conv(u, k):
    n = u.shape[1]
    uf = jnp.fft.rfft(u.astype(jnp.float32), n=2 * n, axis=1)
    kf = jnp.fft.rfft(k, axis=0)
    y = jnp.fft.irfft(uf * kf[None], n=2 * n, axis=1)[:, :n]
    return y.astype(u.dtype)


def hyena_mixer(u, conv_w, conv_b, w1, b1, f1, w2, b2, f2, w3, bias):
    n = u.shape[1]
    z = short_conv(u, conv_w, conv_b)
    x0, x1, v = jnp.split(z, HYENA_ORDER + 1, axis=-1)
    k = hyena_filter(n, w1, b1, f1, w2, b2, f2, w3)
    v = v * x1
    y = fft_long_conv(v, k) + v * bias
    return y * x0


def pool_mixer(p, w_pool, scale):
    b, n, _ = p.shape
    pf = p.astype(jnp.float32)
    t = jnp.arange(n)
    outs = []
    for g, w in enumerate(POOL_WINDOWS):
        xg = pf[..., g * POOL_GROUP:(g + 1) * POOL_GROUP]
        h = w // 2
        cs = jnp.pad(jnp.cumsum(xg, axis=1), ((0, 0), (1, 0), (0, 0)))
        cs = jnp.pad(cs, ((0, 0), (h, h), (0, 0)), mode='edge')
        total = cs[:, 2 * h:2 * h + n] - cs[:, :n]
        count = (jnp.minimum(t + h, n) - jnp.maximum(t - h, 0)).astype(jnp.float32)
        outs.append(total / count[None, :, None] - xg)
    y = jnp.stack(outs, axis=2).astype(p.dtype)
    y = jnp.einsum('blgc,gcd->blgd', y, w_pool).reshape(b, n, POOL_WIDTH)
    return y * scale


def mix_branches(p, attn_out, hy_params, w_pool, pool_scale, g_branch, w_out):
    hy = hyena_mixer(p[..., V_END:HY_END], *hy_params)
    po = pool_mixer(p[..., HY_END:], w_pool, pool_scale)
    merged = jnp.concatenate([
        rmsnorm(attn_out, g_branch[:ATTN_WIDTH]),
        rmsnorm(hy, g_branch[ATTN_WIDTH:ATTN_WIDTH + HYENA_WIDTH]),
        rmsnorm(po, g_branch[ATTN_WIDTH + HYENA_WIDTH:]),
    ], axis=-1)
    return merged @ w_out


def sq_relu_mlp(h, w_up, w_down):
    return jnp.square(jax.nn.relu(h @ w_up)) @ w_down


def setup_inputs(seed: int = 0) -> dict:
    key = jax.random.key(seed)
    ks = jax.random.split(key, 32)
    f32 = jnp.float32

    def nrm(k, shape, s):
        return jax.random.normal(k, shape, f32) * s

    def gain(k, shape):
        return 1.0 + 0.05 * jax.random.normal(k, shape, f32)

    D, L = D_MODEL, DEPTH
    return {
        "x": nrm(ks[0], (BATCH, SEQ, D), 1.0),
        "c": nrm(ks[1], (BATCH, D), 1.0),
        "ctx": nrm(ks[2], (BATCH, CTX_LEN, D), 1.0),
        "c_ctx": nrm(ks[3], (D,), 1.0),
        "w_mod": nrm(ks[4], (L, D, N_MOD * D), D ** -0.5),
        "b_mod": nrm(ks[5], (L, N_MOD * D), 0.02),
        "g_pre_mix": gain(ks[6], (L, D)),
        "g_post_mix": gain(ks[7], (L, D)),
        "g_pre_mlp": gain(ks[8], (L, D)),
        "g_post_mlp": gain(ks[9], (L, D)),
        "w_in": nrm(ks[10], (L, D, IN_WIDTH), D ** -0.5),
        "w_out": nrm(ks[11], (L, MIX_WIDTH, D), MIX_WIDTH ** -0.5),
        "g_branch": gain(ks[12], (L, MIX_WIDTH)),
        "attn_sink": nrm(ks[13], (L, N_HEADS), 0.5),
        "hy_conv_w": nrm(ks[14], (L, HYENA_SHORT, (HYENA_ORDER + 1) * HYENA_WIDTH), HYENA_SHORT ** -0.5),
        "hy_conv_b": nrm(ks[15], (L, (HYENA_ORDER + 1) * HYENA_WIDTH), 0.02),
        "hy_w1": nrm(ks[16], (L, HYENA_EMB_DIM, HYENA_FILTER_HIDDEN), HYENA_EMB_DIM ** -0.5),
        "hy_b1": nrm(ks[17], (L, HYENA_FILTER_HIDDEN), 0.02),
        "hy_freq1": gain(ks[18], (L, HYENA_FILTER_HIDDEN)),
        "hy_w2": nrm(ks[19], (L, HYENA_FILTER_HIDDEN, HYENA_FILTER_HIDDEN), HYENA_FILTER_HIDDEN ** -0.5),
        "hy_b2": nrm(ks[20], (L, HYENA_FILTER_HIDDEN), 0.02),
        "hy_freq2": gain(ks[21], (L, HYENA_FILTER_HIDDEN)),
        "hy_w3": nrm(ks[22], (L, HYENA_FILTER_HIDDEN, 2 * (HYENA_ORDER - 1) * HYENA_WIDTH), HYENA_FILTER_HIDDEN ** -0.5),
        "hy_bias": nrm(ks[23], (L, HYENA_WIDTH), 1.0),
        "pool_w": nrm(ks[24], (L, len(POOL_WINDOWS), POOL_GROUP, POOL_GROUP), POOL_GROUP ** -0.5),
        "pool_scale": 1.0 + 0.1 * jax.random.normal(ks[25], (L, POOL_WIDTH), f32),
        "w_up": nrm(ks[26], (L, D, MLP_HIDDEN), D ** -0.5),
        "w_down": nrm(ks[27], (L, MLP_HIDDEN, D), MLP_HIDDEN ** -0.5),
    }


def reference(x, c, ctx, c_ctx, w_mod, b_mod, g_pre_mix, g_post_mix, g_pre_mlp, g_post_mlp,
              w_in, w_out, g_branch, attn_sink, hy_conv_w, hy_conv_b, hy_w1, hy_b1, hy_freq1,
              hy_w2, hy_b2, hy_freq2, hy_w3, hy_bias, pool_w, pool_scale, w_up, w_down):
    b, n, _ = x.shape
    rows = n // GRID_W
    row = jnp.repeat(jnp.arange(rows, dtype=jnp.int32), GRID_W)
    col = jnp.tile(jnp.arange(GRID_W, dtype=jnp.int32), rows)
    for i in range(DEPTH):
        last = i == DEPTH - 1
        hy_params = (hy_conv_w[i], hy_conv_b[i], hy_w1[i], hy_b1[i], hy_freq1[i],
                     hy_w2[i], hy_b2[i], hy_freq2[i], hy_w3[i], hy_bias[i])
        mod_x = jax.nn.silu(c) @ w_mod[i] + b_mod[i]
        mod_c = jax.nn.silu(c_ctx) @ w_mod[i] + b_mod[i]
        sh1, sc1, gt1, sh2, sc2, gt2 = jnp.split(mod_x[:, None, :], N_MOD, axis=-1)
        csh1, csc1, cgt1, csh2, csc2, cgt2 = jnp.split(mod_c, N_MOD, axis=-1)

        hx = modulate(rmsnorm(x, g_pre_mix[i]), sh1, sc1)
        hc = modulate(rmsnorm(ctx, g_pre_mix[i]), csh1, csc1)
        px = hx @ w_in[i]
        if last:
            kv_ctx = hc @ w_in[i][:, Q_END:V_END]
        else:
            pc = hc @ w_in[i]
            kv_ctx = pc[..., Q_END:V_END]
        k_ctx = kv_ctx[..., :KV_WIDTH].reshape(b, -1, N_KV_HEADS, HEAD_DIM)
        v_ctx = kv_ctx[..., KV_WIDTH:].reshape(b, -1, N_KV_HEADS, HEAD_DIM)

        q = axial_rope(px[..., :Q_END].reshape(b, n, N_HEADS, HEAD_DIM), row, col)
        k = axial_rope(px[..., Q_END:K_END].reshape(b, n, N_KV_HEADS, HEAD_DIM), row, col)
        v = px[..., K_END:V_END].reshape(b, n, N_KV_HEADS, HEAD_DIM)
        attn_x = window_attention(q, k, v, k_ctx, v_ctx, attn_sink[i])
        ox = mix_branches(px, attn_x, hy_params, pool_w[i], pool_scale[i], g_branch[i], w_out[i])
        x = x + gt1 * rmsnorm(ox, g_post_mix[i])

        hx2 = modulate(rmsnorm(x, g_pre_mlp[i]), sh2, sc2)
        x = x + gt2 * rmsnorm(sq_relu_mlp(hx2, w_up[i], w_down[i]), g_post_mlp[i])

        if not last:
            q_ctx = pc[..., :Q_END].reshape(b, -1, N_HEADS, HEAD_DIM)
            attn_c = context_attention(q_ctx, k_ctx, v_ctx, attn_sink[i])
            oc = mix_branches(pc, attn_c, hy_params, pool_w[i], pool_scale[i], g_branch[i], w_out[i])
            ctx = ctx + cgt1 * rmsnorm(oc, g_post_mix[i])
            hc2 = modulate(rmsnorm(ctx, g_pre_mlp[i]), csh2, csc2)
            ctx = ctx + cgt2 * rmsnorm(sq_relu_mlp(hc2, w_up[i], w_down[i]), g_post_mlp[i])
    return x
```

```cpp
#include <hip/hip_runtime.h>
#include <cstdio>
#include <cstdint>
#include <type_traits>
#ifndef MK_PER_PHASE
#define MK_PER_PHASE 0
#endif
#ifndef PG8_AUX_A
#define PG8_AUX_A 0
#endif
namespace pg8 {
#define PG8_LAS __attribute__((address_space(3)))
typedef unsigned short bf16_t;
typedef short bf16x8 __attribute__((ext_vector_type(8)));
typedef float f32x4 __attribute__((ext_vector_type(4)));
typedef unsigned u32x4 __attribute__((ext_vector_type(4)));
constexpr int BM = 256, BK = 64, HALF = 128, HTB = HALF * BK * 2  , STAGE_BYTES = 8 * HTB, NXCD = 8, WGM = 8;

__host__ __device__ __forceinline__ int lds_byte(int r, int c) { const int st = (r >> 4) * 2 + (c >> 5), rr = r & 15, cc = c & 31, ob = rr * 64 + cc * 2; return st * 1024 + (ob ^ (((ob >> 9) & 1) << 5)); }
__host__ __device__ __forceinline__ void stage_rc(int b, int& R, int& C) { const int st = b / 1024, sb = b % 1024, swz = sb ^ (((sb >> 9) & 1) << 5); R = (st >> 1) * 16 + swz / 64; C = (st & 1) * 32 + (swz % 64) / 2; }
__host__ __device__ __forceinline__ int perm32(int rho) { const int n = rho >> 4, i = rho & 15; return 8 * (i >> 2) + 4 * n + (i & 3); }

__device__ __forceinline__ int pg8_tid() { int t = threadIdx.x; asm volatile("" : "+v"(t)); return t; }
struct Unit { int pm, pn, ko, ks; };
struct Gemm { const bf16_t* A; const bf16_t* Bt; int M, N, K, ld, tiledA, tiledB; };

struct StaticOrder {
    int nM, nN, nwg, G, c, wgm;
    __host__ __device__ void init(int M, int N, int G_, int c_, int wgm_ = WGM) { nM = M / BM; nN = N / BM; nwg = nM * nN; G = G_; c = c_; wgm = wgm_; }
    __host__ __device__ bool next(int i, Unit& u) const {
        const long L = (long)i * G + c; if (L >= nwg) return false;
        int wgid = (int)L; { const int q = nwg / NXCD, r = nwg % NXCD, xcd = wgid % NXCD, off = wgid / NXCD; wgid = (xcd < r ? xcd * (q + 1) : r * (q + 1) + (xcd - r) * q) + off; }
        const int nig = wgm * nN, gid = wgid / nig, fm = gid * wgm, gsz = (nM - fm) < wgm ? (nM - fm) : wgm;
        u.pm = fm + ((wgid % nig) % gsz); u.pn = (wgid % nig) / gsz; u.ko = 0; u.ks = -1; return true;
    }
    __device__ __forceinline__ void a_ready(const Unit&) const {}
    __device__ __forceinline__ void done(const Unit&) const {}
};
struct FakeOrder : StaticOrder { __host__ __device__ bool next(int i, Unit& u) const { const bool ok = StaticOrder::next(i, u); u.pm = 0; u.pn = 0; return ok; } };
struct RevOrder : StaticOrder { __host__ __device__ bool next(int i, Unit& u) const { const bool ok = StaticOrder::next(i, u); u.pm = nM - 1 - u.pm; return ok; } };
struct SplitOrder {
    int nM, ntile, nsub, ksub, G, c;
    __host__ __device__ void init(int M, int N, int nslices, int ksub_, int G_, int c_) { nM = M / BM; ntile = nM * (N / BM); nsub = ntile * nslices; ksub = ksub_; G = G_; c = c_; }
    __host__ __device__ bool next(int i, Unit& u) const { const long L = (long)i * G + c; if (L >= nsub) return false; const int s = (int)L, tile = s % ntile, ks = s / ntile;
        u.pm = tile % nM; u.pn = tile / nM; u.ko = ks * ksub; u.ks = ks; return true; }
    __device__ __forceinline__ void a_ready(const Unit&) const {}
    __device__ __forceinline__ void done(const Unit&) const {}
};
__device__ __forceinline__ unsigned cvt_pk_bf16(float lo, float hi) { unsigned r; asm volatile("v_cvt_pk_bf16_f32 %0, %1, %2" : "=v"(r) : "v"(lo), "v"(hi)); return r; }
template <int ACT> struct EpiOut {
    static constexpr bool PERM = true, AFTER_DRAIN = false;
    bf16_t* O; int ldc; int tiled;
    __device__ __forceinline__ void operator()(const f32x4 (&acc)[2][2][4][2], const Unit& u, int wr, int wc, int fr, int fq) const {
        const int row0 = u.pm * BM + wr * 64 + fr; const int col0 = u.pn * BM + wc * 32 + 8 * fq;
#pragma unroll
        for (int ai = 0; ai < 2; ++ai)
#pragma unroll
            for (int m = 0; m < 4; ++m) { const int row = row0 + ai * HALF + m * 16; bf16_t* rowp = O + (size_t)row * ldc + col0;
#pragma unroll
                for (int bj = 0; bj < 2; ++bj) { f32x4 v0 = acc[ai][bj][m][0], v1 = acc[ai][bj][m][1];
                    if (ACT == 1) {
#pragma unroll
                        for (int j = 0; j < 4; ++j) { const float a = v0[j] > 0.f ? v0[j] : 0.f, b = v1[j] > 0.f ? v1[j] : 0.f; v0[j] = a * a; v1[j] = b * b; } }
                    u32x4 w; w.x = cvt_pk_bf16(v0[0], v0[1]); w.y = cvt_pk_bf16(v0[2], v0[3]); w.z = cvt_pk_bf16(v1[0], v1[1]); w.w = cvt_pk_bf16(v1[2], v1[3]);
                    if (tiled) { const int col = col0 + bj * HALF; *(u32x4*)(O + ((size_t)(row >> 8) * (ldc >> 6) + (col >> 6)) * 16384 + (size_t)((row & 255) * 64 + (col & 63))) = w; }
                    else *(u32x4*)(rowp + bj * HALF) = w; } }
    }
};
struct EpiPart {
    static constexpr bool PERM = false, AFTER_DRAIN = false;
    float* P; int ldc; size_t slice_stride;
    __device__ __forceinline__ void operator()(const f32x4 (&acc)[2][2][4][2], const Unit& u, int wr, int wc, int fr, int fq) const {
        const int row0 = u.pm * BM + wr * 64 + fr, col0 = u.pn * BM + wc * 32 + 4 * fq; float* base = P + (size_t)u.ks * slice_stride;
#pragma unroll
        for (int ai = 0; ai < 2; ++ai)
#pragma unroll
            for (int m = 0; m < 4; ++m) { float* rowp = base + (size_t)(row0 + ai * HALF + m * 16) * ldc + col0;
#pragma unroll
                for (int bj = 0; bj < 2; ++bj)
#pragma unroll
                    for (int n = 0; n < 2; ++n) *(f32x4*)(rowp + bj * HALF + n * 16) = acc[ai][bj][m][n]; }
    }
};
template <class Epi, class Sched, bool ALIGN_EPI = false, bool SP2 = false>
__device__ __forceinline__ void gemm_phase(PG8_LAS unsigned char* lds, const Gemm g, const Sched& S, const Epi& E) {
    const int tid = pg8_tid(), wid = __builtin_amdgcn_readfirstlane(tid >> 6), lane = tid & 63, wr = wid >> 2, wc = wid & 3, fr = lane & 15, fq = lane >> 4;
    const int K = g.ld, nt = g.K / BK;
    unsigned voffA[2], voffB[2];
#pragma unroll
    for (int i = 0; i < 2; ++i) { int R, C; stage_rc(tid * 16 + i * 8192, R, C); const int Rb = Epi::PERM ? ((R & ~31) + perm32(R & 31)) : R;
        voffA[i] = g.tiledA ? (unsigned)(R * BK + C) * 2u : (unsigned)(R * K + C) * 2u; voffB[i] = g.tiledB ? (unsigned)(Rb * BK + C) * 2u : (unsigned)(Rb * K + C) * 2u; }
    const size_t kstepA = g.tiledA ? (size_t)(BM * BK * 2) : (size_t)(BK * 2), kstepB = g.tiledB ? (size_t)(BM * BK * 2) : (size_t)(BK * 2);
    const size_t hstep = (size_t)HALF * K * 2, hstepA = g.tiledA ? (size_t)(HALF * BK * 2) : hstep, hstepB = g.tiledB ? (size_t)(HALF * BK * 2) : hstep;
    const size_t koA = g.tiledA ? (size_t)(BM * 2) : 2, koB = g.tiledB ? (size_t)(BM * 2) : 2;
    const size_t tstep = 2 * hstep;
    const unsigned ldsw = (unsigned)wid * 1024u;
    const int aoff = lds_byte(wr * 64 + fr, fq * 8), boff = lds_byte(wc * 32 + fr, fq * 8);
#define PG8_SA(b, h) (((b) * 2 + (h)) * HTB)
#define PG8_SB(b, h) ((4 + (b) * 2 + (h)) * HTB)
#define PG8_STAGE(bufoff, gbase, voff) do { _Pragma("unroll") for (int _i = 0; _i < 2; ++_i) \
        __builtin_amdgcn_global_load_lds((const unsigned*)((const char*)(gbase) + (voff)[_i]), (PG8_LAS unsigned*)(lds + (bufoff) + ldsw + _i * 8192), 16, 0, 0); } while (0)
#define PG8_LDA(dst, b, h) do { _Pragma("unroll") for (int m = 0; m < 4; ++m) _Pragma("unroll") for (int k = 0; k < 2; ++k) dst[m][k] = *(const PG8_LAS bf16x8*)(lds + PG8_SA(b, h) + aoff + m * 2048 + k * 1024); } while (0)
#define PG8_LDB(dst, b, h) do { _Pragma("unroll") for (int n = 0; n < 2; ++n) _Pragma("unroll") for (int k = 0; k < 2; ++k) dst[n][k] = *(const PG8_LAS bf16x8*)(lds + PG8_SB(b, h) + boff + n * 2048 + k * 1024); } while (0)
#define PG8_MMA(ai, bj, At, Bt) do { __builtin_amdgcn_s_setprio(1); _Pragma("unroll") for (int m = 0; m < 4; ++m) _Pragma("unroll") for (int n = 0; n < 2; ++n) _Pragma("unroll") for (int k = 0; k < 2; ++k) \
        acc[ai][bj][m][n] = __builtin_amdgcn_mfma_f32_16x16x32_bf16(Bt[n][k], At[m][k], acc[ai][bj][m][n], 0, 0, 0); __builtin_amdgcn_s_setprio(0); } while (0)
#define PG8_WAIT_V(n) asm volatile("s_waitcnt vmcnt(" #n ")" ::: "memory")
#define PG8_WAIT_L(n) asm volatile("s_waitcnt lgkmcnt(" #n ")" ::: "memory")
#define PG8_BAR __builtin_amdgcn_s_barrier()
#define PG8_SCHED __builtin_amdgcn_sched_barrier(0)
    Unit cur, nxt; int ui = 0;
    if (!S.next(0, cur)) return;
    f32x4 acc[2][2][4][2];
#pragma unroll
    for (int a = 0; a < 2; ++a)
#pragma unroll
        for (int b = 0; b < 2; ++b)
#pragma unroll
            for (int m = 0; m < 4; ++m)
#pragma unroll
                for (int n = 0; n < 2; ++n) acc[a][b][m][n] = (f32x4){0.f, 0.f, 0.f, 0.f};
    bf16x8 At[4][2], B0[2][2], B1[2][2];
    const char* cA = (const char*)g.A + (size_t)cur.pm * tstep + (size_t)cur.ko * koA; const char* cB = (const char*)g.Bt + (size_t)cur.pn * tstep + (size_t)cur.ko * koB;
    S.a_ready(cur);
    if constexpr (SP2) {
        PG8_STAGE(PG8_SB(0, 0), cB, voffB); PG8_STAGE(PG8_SB(0, 1), cB + hstepB, voffB); PG8_STAGE(PG8_SA(0, 0), cA, voffA); PG8_STAGE(PG8_SA(0, 1), cA + hstepA, voffA);
        if (wr == 1) PG8_BAR;
        PG8_WAIT_V(2); PG8_BAR;
        PG8_STAGE(PG8_SB(1, 0), cB + kstepB, voffB); PG8_STAGE(PG8_SA(1, 0), cA + kstepA, voffA); PG8_STAGE(PG8_SB(1, 1), cB + hstepB + kstepB, voffB);
        PG8_WAIT_V(6); PG8_BAR;
    } else {
        PG8_STAGE(PG8_SB(0, 0), cB, voffB); PG8_STAGE(PG8_SA(0, 0), cA, voffA); PG8_STAGE(PG8_SB(0, 1), cB + hstepB, voffB); PG8_STAGE(PG8_SA(0, 1), cA + hstepA, voffA);
        if (wr == 1) PG8_BAR;
        PG8_WAIT_V(4); PG8_BAR;
        PG8_STAGE(PG8_SB(1, 0), cB + kstepB, voffB); PG8_STAGE(PG8_SA(1, 0), cA + kstepA, voffA); PG8_STAGE(PG8_SB(1, 1), cB + hstepB + kstepB, voffB);
        PG8_WAIT_V(6); PG8_BAR;
    }
    for (;;) {
        const bool has_next = S.next(ui + 1, nxt);
        const char* nA = has_next ? (const char*)g.A + (size_t)nxt.pm * tstep + (size_t)nxt.ko * koA : cA; const char* nB = has_next ? (const char*)g.Bt + (size_t)nxt.pn * tstep + (size_t)nxt.ko * koB : cB;
        for (int t = 0; t < nt; t += 2) {
            const bool last = (t == nt - 2);
            const char* a1 = cA + (size_t)(t + 1) * kstepA;
            const char* a2 = last ? nA : cA + (size_t)(t + 2) * kstepA; const char* b2 = last ? nB : cB + (size_t)(t + 2) * kstepB;
            const char* a3 = a2 + kstepA; const char* b3 = b2 + kstepB;
            if (last && has_next) S.a_ready(nxt);
            if constexpr (SP2) {
            PG8_LDB(B0, 0, 0); PG8_LDB(B1, 0, 1); PG8_SCHED; PG8_LDA(At, 0, 0); PG8_STAGE(PG8_SA(1, 1), a1 + hstepA, voffA);
            PG8_WAIT_V(8); PG8_WAIT_L(0); PG8_BAR; PG8_MMA(0, 0, At, B0); PG8_MMA(0, 1, At, B1); PG8_BAR; PG8_SCHED;
            PG8_LDA(At, 0, 1); PG8_STAGE(PG8_SB(0, 0), b2, voffB); PG8_STAGE(PG8_SB(0, 1), b2 + hstepB, voffB); PG8_STAGE(PG8_SA(0, 0), a2, voffA);
            PG8_WAIT_V(8); PG8_WAIT_L(0); PG8_BAR; PG8_MMA(1, 0, At, B0); PG8_MMA(1, 1, At, B1); PG8_BAR; PG8_SCHED;
            PG8_LDB(B0, 1, 0); PG8_LDB(B1, 1, 1); PG8_SCHED; PG8_LDA(At, 1, 0); PG8_STAGE(PG8_SA(0, 1), a2 + hstepA, voffA);
            PG8_WAIT_V(8); PG8_WAIT_L(0); PG8_BAR; PG8_MMA(0, 0, At, B0); PG8_MMA(0, 1, At, B1); PG8_BAR; PG8_SCHED;
            PG8_LDA(At, 1, 1); PG8_STAGE(PG8_SB(1, 0), b3, voffB); PG8_STAGE(PG8_SB(1, 1), b3 + hstepB, voffB); PG8_STAGE(PG8_SA(1, 0), a3, voffA);
            PG8_WAIT_V(8); PG8_WAIT_L(0); PG8_BAR; PG8_MMA(1, 0, At, B0); PG8_MMA(1, 1, At, B1); PG8_BAR; PG8_SCHED;
            } else {
            PG8_LDB(B0, 0, 0); PG8_SCHED; PG8_LDA(At, 0, 0); PG8_STAGE(PG8_SA(1, 1), a1 + hstepA, voffA);
            PG8_WAIT_L(8); PG8_BAR; PG8_WAIT_L(0); PG8_MMA(0, 0, At, B0); PG8_BAR; PG8_SCHED;
            PG8_LDB(B1, 0, 1); PG8_STAGE(PG8_SB(0, 0), b2, voffB);
            PG8_BAR; PG8_WAIT_L(0); PG8_MMA(0, 1, At, B1); PG8_BAR;
            PG8_LDA(At, 0, 1); PG8_STAGE(PG8_SA(0, 0), a2, voffA);
            PG8_BAR; PG8_WAIT_L(0); PG8_MMA(1, 0, At, B0); PG8_BAR; PG8_SCHED;
            PG8_STAGE(PG8_SB(0, 1), b2 + hstepB, voffB);
            PG8_WAIT_V(6); PG8_BAR; PG8_MMA(1, 1, At, B1); PG8_BAR;
            PG8_LDB(B0, 1, 0); PG8_SCHED; PG8_LDA(At, 1, 0); PG8_STAGE(PG8_SA(0, 1), a2 + hstepA, voffA);
            PG8_WAIT_L(8); PG8_BAR; PG8_WAIT_L(0); PG8_MMA(0, 0, At, B0); PG8_BAR; PG8_SCHED;
            PG8_LDB(B1, 1, 1); PG8_STAGE(PG8_SB(1, 0), b3, voffB);
            PG8_BAR; PG8_WAIT_L(0); PG8_MMA(0, 1, At, B1); PG8_BAR;
            PG8_LDA(At, 1, 1); PG8_STAGE(PG8_SA(1, 0), a3, voffA);
            PG8_BAR; PG8_WAIT_L(0); PG8_MMA(1, 0, At, B0); PG8_BAR; PG8_SCHED;
            PG8_STAGE(PG8_SB(1, 1), b3 + hstepB, voffB);
            PG8_WAIT_V(6); PG8_BAR; PG8_MMA(1, 1, At, B1); PG8_BAR;
            }
        }
        if constexpr (ALIGN_EPI) { if (wr == 0) PG8_BAR; }
        if constexpr (!Epi::AFTER_DRAIN) { E(acc, cur, wr, wc, fr, fq); S.done(cur); }
        if (!has_next) break;
#pragma unroll
        for (int a = 0; a < 2; ++a)
#pragma unroll
            for (int b = 0; b < 2; ++b)
#pragma unroll
                for (int m = 0; m < 4; ++m)
#pragma unroll
                    for (int n = 0; n < 2; ++n) acc[a][b][m][n] = (f32x4){0.f, 0.f, 0.f, 0.f};
        cur = nxt; cA = nA; cB = nB; ++ui;
        if constexpr (ALIGN_EPI) { if (wr == 1) PG8_BAR; }
    }
    PG8_WAIT_V(0);
    if constexpr (!ALIGN_EPI) { if (wr == 0) PG8_BAR; }
    PG8_BAR;
    if constexpr (Epi::AFTER_DRAIN) { E.fused(acc, cur, wr, wc, fr, fq, lds, wid, lane); S.done(cur); }
#undef PG8_SA
#undef PG8_SB
#undef PG8_STAGE
#undef PG8_LDA
#undef PG8_LDB
#undef PG8_MMA
#undef PG8_WAIT_V
#undef PG8_WAIT_L
#undef PG8_BAR
#undef PG8_SCHED
}
}
#define LAS __attribute__((address_space(3)))
#define XB_TMO      128
#define XB_XCNT(j)  (256  + 64 * (j))
#define XB_XSUB(j)  (1280 + 64 * (j))
#define XB_XGEN(j)  (2304 + 64 * (j))
#define XB_TOP      3328
#define XB_TOPGEN   3392
#define XCD_BAR_WORDS 3456
#define XB_SPIN_CAP (1u << 18)

__device__ __forceinline__ unsigned xb_ld(unsigned* p)              { return __hip_atomic_load(p, __ATOMIC_RELAXED, __HIP_MEMORY_SCOPE_AGENT); }
__device__ __forceinline__ unsigned xb_add(unsigned* p, unsigned v) { return __hip_atomic_fetch_add(p, v, __ATOMIC_RELAXED, __HIP_MEMORY_SCOPE_AGENT); }
__device__ __forceinline__ unsigned xb_xcc_id() { return (unsigned)__builtin_amdgcn_s_getreg((3 << 11) | 20) & 0xFu; }
#define XB_SPIN(cond, bar) do { unsigned _sp = 0; while (cond) { __builtin_amdgcn_s_sleep(1); \
    if ((++_sp & 255u) == 0u) { if (xb_ld(&(bar)[XB_TMO])) break; if (_sp > XB_SPIN_CAP) { atomicAdd(&(bar)[XB_TMO], 1u); break; } } } } while (0)

struct XcdBarrier {
    unsigned* bar; unsigned x;
    volatile LAS unsigned* st;
};

__device__ __forceinline__ XcdBarrier xcd_barrier_post(unsigned* bar, volatile LAS unsigned* st) {
    XcdBarrier b; b.bar = bar; b.x = xb_xcc_id(); b.st = st;
    if (threadIdx.x == 0) (void)xb_add(&bar[XB_XCNT(b.x)], 1u);
    return b;
}
__device__ __forceinline__ void xcd_barrier_complete(unsigned* bar, unsigned x, unsigned& nloc, unsigned& nx) {
    const unsigned G = gridDim.x * gridDim.y * gridDim.z;
    unsigned sum, cnt, mine, sp = 0u;
    for (;;) {
        sum = 0u; cnt = 0u; mine = 0u;
#pragma unroll
        for (unsigned j = 0; j < 16; ++j) { const unsigned c = xb_ld(&bar[XB_XCNT(j)]); sum += c; cnt += (c > 0u) ? 1u : 0u; mine = (j == x) ? c : mine; }
        if (sum == G) break;
        __builtin_amdgcn_s_sleep(1);
        if ((++sp & 255u) == 0u) { if (xb_ld(&bar[XB_TMO])) break; if (sp > XB_SPIN_CAP) { atomicAdd(&bar[XB_TMO], 1u); break; } }
    }
    nloc = mine > 0u ? mine : 1u; nx = cnt > 0u ? cnt : 1u;
}

__device__ __forceinline__ void xcd_barrier(const XcdBarrier& b) {
    asm volatile("s_waitcnt vmcnt(0)" ::: "memory");
    __syncthreads();
    if (threadIdx.x == 0) {
        unsigned* bar = b.bar;
        __builtin_amdgcn_s_waitcnt(0);
        unsigned nloc = b.st[0], nx = b.st[1];
        if (nloc == 0u) { xcd_barrier_complete(bar, b.x, nloc, nx); b.st[0] = nloc; b.st[1] = nx; }
        const unsigned old = xb_add(&bar[XB_XSUB(b.x)], 1u);
        const unsigned gen = old / nloc;
        if (old + 1u == (gen + 1u) * nloc) {
            __builtin_amdgcn_fence(__ATOMIC_RELEASE, "agent");
            asm volatile("s_waitcnt vmcnt(0)" ::: "memory");
            const unsigned og = xb_add(&bar[XB_TOP], 1u);
            const unsigned tg = og / nx;
            if (og + 1u == (tg + 1u) * nx) xb_add(&bar[XB_TOPGEN], 1u);
            else XB_SPIN(xb_ld(&bar[XB_TOPGEN]) == tg, bar);
            __builtin_amdgcn_fence(__ATOMIC_ACQUIRE, "agent");
            xb_add(&bar[XB_XGEN(b.x)], 1u);
            asm volatile("s_waitcnt vmcnt(0)" ::: "memory");
        } else {
            XB_SPIN(xb_ld(&bar[XB_XGEN(b.x)]) == gen, bar);
            __builtin_amdgcn_fence(__ATOMIC_ACQUIRE, "agent");
            asm volatile("s_waitcnt vmcnt(0)" ::: "memory");
        }
    }
    __syncthreads();
}
constexpr int DM = 2048, NB = 2, SEQ = 16384, DEPTH = 4, CTXL = 256;
constexpr int NLAT = NB * SEQ, NCTX = NB * CTXL, MROWS = NLAT + NCTX;
constexpr int INW = 3584, Q_END = 1024, K_END = 1280, V_END = 1536, HY_END = 3072;
constexpr int HYW = 512, PLW = 512, MLPH = 8192, MODW = 6 * DM;
constexpr float EPS = 1e-6f;
constexpr int NIN = 28;
enum { I_X = 0, I_C, I_CTX, I_CCTX, I_WMOD, I_BMOD, I_GPREMIX, I_GPOSTMIX, I_GPREMLP, I_GPOSTMLP, I_WIN, I_WOUT, I_GBRANCH, I_SINK, I_HCW, I_HCB,
       I_HW1, I_HB1, I_HF1, I_HW2, I_HB2, I_HF2, I_HW3, I_HBIAS, I_POOLW, I_POOLS, I_WUP, I_WDOWN };

constexpr size_t MiB = 1u << 20;
constexpr size_t WS_CTL = 0, CTL_ZERO_BYTES = 1 * MiB;
constexpr size_t WS_MOD = 1 * MiB;
constexpr size_t WS_ROPE = 2 * MiB;
constexpr size_t WS_TW = 2 * MiB + 128 * 1024;
constexpr size_t WS_FPART = 3 * MiB;
constexpr size_t WS_XC = 6 * MiB;
constexpr size_t WS_MODP = 10 * MiB;
constexpr size_t WS_YA = 28 * MiB;
constexpr size_t WS_WT = 60 * MiB;
constexpr size_t WT_IN = 0, WT_OUT = 14 * MiB, WT_UP = 22 * MiB, WT_DOWN = 54 * MiB, WT_POOL = 86 * MiB, WT_LAYER = 86 * MiB + MiB / 2;
constexpr size_t WS_HX = 406 * MiB;
constexpr size_t WS_OX = 536 * MiB;
constexpr size_t WS_U = 666 * MiB;
constexpr size_t WS_H = WS_U;
constexpr size_t WS_PX = WS_U;
constexpr size_t WS_MERGED = WS_U + 228 * MiB;
constexpr size_t WS_POOLED = WS_U + 358 * MiB;
constexpr size_t WS_PORAW = WS_U + 391 * MiB;
constexpr size_t WS_VT = WS_U + 424 * MiB;
constexpr size_t WS_YT = WS_U + 457 * MiB;
constexpr size_t WS_HF = 1190 * MiB;
constexpr size_t WS_HFC = WS_HF + 64 * MiB;
constexpr size_t WS_SPEC = 1255 * MiB;
constexpr size_t WS_PART = WS_SPEC;
constexpr size_t WS_XB = 1384 * MiB;
constexpr size_t WS_END = 1514 * MiB;
static_assert(WS_WT + DEPTH * WT_LAYER <= WS_HX && WS_YT + (size_t)512 * MROWS * 4 <= WS_HF && WS_H + (size_t)MROWS * MLPH * 2 <= WS_HF, "d_ws map");

constexpr int LDS_RED = 139264;
constexpr int LDS_MISC = 140288;
constexpr int LDS_BYTES = 147456;

typedef unsigned short bf16;
typedef float f32x4 __attribute__((ext_vector_type(4)));
typedef float cf32 __attribute__((ext_vector_type(2)));
typedef short bf16x8 __attribute__((ext_vector_type(8)));
typedef short s16x4 __attribute__((ext_vector_type(4)));
typedef float f32x16 __attribute__((ext_vector_type(16)));
typedef unsigned u32x4 __attribute__((ext_vector_type(4)));
typedef unsigned u32x2 __attribute__((ext_vector_type(2)));
#define make_cf32(a, b) ((cf32){(a), (b)})

__device__ __forceinline__ unsigned f2bf(float f) { unsigned u = __builtin_bit_cast(unsigned, f); return (u + 0x7fffu + ((u >> 16) & 1u)) >> 16; }
__device__ __forceinline__ unsigned pk2(float lo, float hi) { return f2bf(lo) | (f2bf(hi) << 16); }
__device__ __forceinline__ float bf2f(unsigned short b) { return __builtin_bit_cast(float, (unsigned)b << 16); }
__device__ __forceinline__ float bflo(unsigned w) { return __builtin_bit_cast(float, w << 16); }
__device__ __forceinline__ float bfhi(unsigned w) { return __builtin_bit_cast(float, w & 0xffff0000u); }
__device__ __forceinline__ float wave_sum(float v) {
#pragma unroll
    for (int o = 1; o < 64; o <<= 1) v += __shfl_xor(v, o);
    return v;
}
struct Ctx {
    const float* in[NIN]; float* out; unsigned char* ws;
    LAS unsigned char* lds; char* ldsg;
    int tid, lane, wave, bid, G;
};
#define WSP(T, off) ((T*)(C.ws + (off)))

#define FFT_DEV __device__ __forceinline__
#define FFT_LDS LAS
#define FFT_SINCOSPI(x, s, c) do { *(s) = sinpif(x); *(c) = cospif(x); } while (0)
#define FFT_SYNC() __syncthreads()
__device__ __forceinline__ int fft_launder(int t) { asm volatile("" : "+v"(t)); return t; }
#define FFT_LAUNDER(t) fft_launder(t)
constexpr int FFT_N = 16384;
FFT_DEV int fpad(int i) { return i + (i >> 4); }
constexpr int FFT_SLOTS = FFT_N + (FFT_N >> 4);
FFT_DEV cf32 cadd(cf32 a, cf32 b) { return a + b; }
FFT_DEV cf32 csub(cf32 a, cf32 b) { return a - b; }
FFT_DEV cf32 cmul(cf32 a, cf32 b) { return a.xx * b + make_cf32(-a.y, a.y) * b.yx; }
FFT_DEV cf32 cmulc(cf32 a, cf32 b) { return b.xx * a + make_cf32(b.y, -b.y) * a.yx; }
template <bool INV> FFT_DEV void dft4(cf32& a, cf32& b, cf32& c, cf32& d) {
    const cf32 s0 = cadd(a, c), s1 = csub(a, c), s2 = cadd(b, d), s3 = csub(b, d);
    const cf32 t = INV ? make_cf32(-s3.y, s3.x) : make_cf32(s3.y, -s3.x);
    a = cadd(s0, s2); c = csub(s0, s2); b = cadd(s1, t); d = csub(s1, t);
}
template <bool INV> FFT_DEV void dft16(cf32 (&v)[16]) {
#pragma unroll
    for (int b = 0; b < 4; ++b) dft4<INV>(v[b], v[4 + b], v[8 + b], v[12 + b]);
    const float C1 = 0.92387953251128674f, S1 = 0.38268343236508977f, R2 = 0.70710678118654752f;
    const cf32 w1 = make_cf32(C1, INV ? S1 : -S1), w2 = make_cf32(R2, INV ? R2 : -R2), w3 = make_cf32(S1, INV ? C1 : -C1);
    const cf32 w6 = make_cf32(-R2, INV ? R2 : -R2), w9 = make_cf32(-C1, INV ? -S1 : S1);
    const cf32 w4 = make_cf32(0.f, INV ? 1.f : -1.f);
    v[4 * 1 + 1] = cmul(v[4 * 1 + 1], w1); v[4 * 1 + 2] = cmul(v[4 * 1 + 2], w2); v[4 * 1 + 3] = cmul(v[4 * 1 + 3], w3);
    v[4 * 2 + 1] = cmul(v[4 * 2 + 1], w2); v[4 * 2 + 2] = cmul(v[4 * 2 + 2], w4); v[4 * 2 + 3] = cmul(v[4 * 2 + 3], w6);
    v[4 * 3 + 1] = cmul(v[4 * 3 + 1], w3); v[4 * 3 + 2] = cmul(v[4 * 3 + 2], w6); v[4 * 3 + 3] = cmul(v[4 * 3 + 3], w9);
#pragma unroll
    for (int q1 = 0; q1 < 4; ++q1) dft4<INV>(v[4 * q1], v[4 * q1 + 1], v[4 * q1 + 2], v[4 * q1 + 3]);
}
constexpr int FFT_TW0 = 0, FFT_TW1 = 15 * 1024, FFT_TW2 = 15 * 1024 + 15 * 64, FFT_TWN = 15 * 1024 + 15 * 64 + 15 * 4;
template <int L> struct fft_twbase { static constexpr int v = L == 16384 ? FFT_TW0 : (L == 1024 ? FFT_TW1 : FFT_TW2); };
template <int L, bool INV> FFT_DEV void fft_pass16(FFT_LDS cf32* buf, int tid, const cf32* tw) {
    constexpr int S = L / 16;
#pragma unroll 1
    for (int k = 0; k < 2; ++k) {
        const int bf = tid + 512 * k, g = bf / S, j = bf % S, base = g * L + j;
        cf32 v[16], w[16];
        const cf32* twj = tw + fft_twbase<L>::v + j;
#pragma unroll
        for (int q = 1; q < 16; ++q) w[q] = twj[(q - 1) * S];
        if (!INV) {
#pragma unroll
            for (int m = 0; m < 16; ++m) v[m] = buf[fpad(base + m * S)];
            dft16<false>(v);
#pragma unroll
            for (int q = 1; q < 16; ++q) { const int p = 4 * (q & 3) + (q >> 2); v[p] = cmul(v[p], w[q]); }
#pragma unroll
            for (int q = 0; q < 16; ++q) buf[fpad(base + q * S)] = v[4 * (q & 3) + (q >> 2)];
        } else {
#pragma unroll
            for (int q = 0; q < 16; ++q) v[q] = buf[fpad(base + q * S)];
#pragma unroll
            for (int q = 1; q < 16; ++q) v[q] = cmulc(v[q], w[q]);
            dft16<true>(v);
#pragma unroll
            for (int m = 0; m < 16; ++m) buf[fpad(base + m * S)] = v[4 * (m & 3) + (m >> 2)];
        }
    }
}
template <bool INV> FFT_DEV void fft_pass4(FFT_LDS cf32* buf, int tid) {
#pragma unroll 1
    for (int k = 0; k < 8; ++k) {
        const int b0 = fpad(4 * (tid + 512 * k));
        cf32 a = buf[b0], b = buf[b0 + 1], c = buf[b0 + 2], d = buf[b0 + 3];
        dft4<INV>(a, b, c, d);
        buf[b0] = a; buf[b0 + 1] = b; buf[b0 + 2] = c; buf[b0 + 3] = d;
    }
}
#ifndef FFT_LAUNDER
#define FFT_LAUNDER(t) (t)
#endif
#define FFT_FORWARD(buf, tid, tw) do { fft_pass16<16384, false>(buf, FFT_LAUNDER(tid), tw); FFT_SYNC(); fft_pass16<1024, false>(buf, FFT_LAUNDER(tid), tw); FFT_SYNC(); \
    fft_pass16<64, false>(buf, FFT_LAUNDER(tid), tw); FFT_SYNC(); fft_pass4<false>(buf, FFT_LAUNDER(tid)); FFT_SYNC(); } while (0)
#define FFT_INVERSE(buf, tid, tw) do { fft_pass4<true>(buf, FFT_LAUNDER(tid)); FFT_SYNC(); fft_pass16<64, true>(buf, FFT_LAUNDER(tid), tw); FFT_SYNC(); \
    fft_pass16<1024, true>(buf, FFT_LAUNDER(tid), tw); FFT_SYNC(); fft_pass16<16384, true>(buf, FFT_LAUNDER(tid), tw); FFT_SYNC(); } while (0)
namespace att {
constexpr float SCALE = 0.088388347648318440f;
constexpr float THR = 8.f;
#define KSWZ(row, colB) ((row) * 256 + ((colB) ^ (((row) & 7) << 4)))
#define SBAR() __builtin_amdgcn_sched_barrier(0)
__device__ __forceinline__ int crow(int r, int hi) { return (r & 3) + 8 * (r >> 2) + 4 * hi; }
__device__ __forceinline__ unsigned cvtpk(float lo, float hi) {
  unsigned r; asm volatile("v_cvt_pk_bf16_f32 %0, %1, %2" : "=v"(r) : "v"(lo), "v"(hi)); return r;
}
__device__ __forceinline__ void partialSM(f32x16& p0, f32x16& p1, float& m_reg, float& mn, float& alpha) {
  constexpr float C = SCALE * 1.4426950408889634f;
  float pmax = p0[0]; for (int r = 1; r < 16; ++r) pmax = fmaxf(pmax, p0[r]); for (int r = 0; r < 16; ++r) pmax = fmaxf(pmax, p1[r]);
  { auto rr = __builtin_amdgcn_permlane32_swap(__float_as_uint(pmax), __float_as_uint(pmax), false, false);
    pmax = fmaxf(__uint_as_float(rr[0]), __uint_as_float(rr[1])); }
  if (__builtin_expect(__all(pmax - m_reg <= THR / SCALE), 1)) { mn = m_reg; alpha = 1.f; }
  else { mn = fmaxf(m_reg, pmax); alpha = __builtin_amdgcn_exp2f((m_reg - mn) * C); m_reg = mn; }
  float mnC = -mn * C;
  for (int r = 0; r < 16; ++r) p0[r] = fmaf(p0[r], C, mnC); for (int r = 0; r < 16; ++r) p1[r] = fmaf(p1[r], C, mnC);
  for (int r = 0; r < 16; ++r) p0[r] = __builtin_amdgcn_exp2f(p0[r]);
}
__device__ __forceinline__ void finishSM(f32x16& p0, f32x16& p1, float alpha, float& l_reg, bf16x8& pa0, bf16x8& pa1, bf16x8& pa2, bf16x8& pa3) {
  for (int r = 0; r < 16; ++r) p1[r] = __builtin_amdgcn_exp2f(p1[r]);
  float ps = 0; for (int r = 0; r < 16; ++r) ps += p0[r]; for (int r = 0; r < 16; ++r) ps += p1[r];
  { auto rr = __builtin_amdgcn_permlane32_swap(__float_as_uint(ps), __float_as_uint(ps), false, false);
    ps = __uint_as_float(rr[0]) + __uint_as_float(rr[1]); }
  l_reg = l_reg * alpha + ps;
#define PK4(P, BASE, OUT) do { unsigned a0 = cvtpk(P[BASE + 0], P[BASE + 1]), a1 = cvtpk(P[BASE + 2], P[BASE + 3]);   \
    unsigned b0 = cvtpk(P[BASE + 4], P[BASE + 5]), b1 = cvtpk(P[BASE + 6], P[BASE + 7]);                              \
    auto r0 = __builtin_amdgcn_permlane32_swap(a0, b0, false, false); auto r1 = __builtin_amdgcn_permlane32_swap(a1, b1, false, false); \
    u32x4 w = {r0[0], r1[0], r0[1], r1[1]}; OUT = *reinterpret_cast<bf16x8*>(&w); } while (0)
  PK4(p0, 0, pa0); PK4(p0, 8, pa1); PK4(p1, 0, pa2); PK4(p1, 8, pa3);
#undef PK4
}
__device__ __forceinline__ void qkt(f32x16& p0, f32x16& p1, const char* Ks, const bf16x8* qr, int r32, int hi) {
  p0 = f32x16{}; p1 = f32x16{};
  for (int d0 = 0; d0 < 8; ++d0) { int cb = (d0 * 16 + hi * 8) * 2;
    bf16x8 b0 = *reinterpret_cast<const bf16x8*>((const char*)Ks + KSWZ(r32, cb));
    bf16x8 b1 = *reinterpret_cast<const bf16x8*>((const char*)Ks + KSWZ(32 + r32, cb));
    p0 = __builtin_amdgcn_mfma_f32_32x32x16_bf16(b0, qr[d0], p0, 0, 0, 0);
    p1 = __builtin_amdgcn_mfma_f32_32x32x16_bf16(b1, qr[d0], p1, 0, 0, 0); }
}
__device__ __forceinline__ int v_st(int k, int c) { const int kk = (k & ~0xC) | ((k & 4) << 1) | ((k & 8) >> 1); return ((kk >> 3) * 4 + (c >> 5)) * 512 + ((kk & 7) * 32 + (c & 31)) * 2; }
__device__ __forceinline__ int v_rd_base(int lane) { return ((lane & 3) << 3) | (((lane >> 2) & 3) << 6) | (((lane >> 4) & 1) << 5) | (((lane >> 5) & 1) << 8); }
constexpr int v_rd_off(int d0, int ks, int half) { return d0 * 512 + ks * 4096 + half * 2048; }
template <int OFF> __device__ __forceinline__ s16x4 tr_read(int vb) {
  s16x4 r; asm volatile("ds_read_b64_tr_b16 %0, %1 offset:%2" : "=&v"(r) : "v"(vb), "i"(OFF) : "memory"); return r;
}
template <int D0> __device__ __forceinline__ void pv_one(f32x16& od, int vb, bf16x8 pa0, bf16x8 pa1, bf16x8 pa2, bf16x8 pa3) {
  const s16x4 l0 = tr_read<v_rd_off(D0, 0, 0)>(vb), h0 = tr_read<v_rd_off(D0, 0, 1)>(vb), l1 = tr_read<v_rd_off(D0, 1, 0)>(vb), h1 = tr_read<v_rd_off(D0, 1, 1)>(vb);
  const s16x4 l2 = tr_read<v_rd_off(D0, 2, 0)>(vb), h2 = tr_read<v_rd_off(D0, 2, 1)>(vb), l3 = tr_read<v_rd_off(D0, 3, 0)>(vb), h3 = tr_read<v_rd_off(D0, 3, 1)>(vb);
  asm volatile("s_waitcnt lgkmcnt(0)" ::: "memory"); SBAR();
#define PK(L, H) (bf16x8){L[0], L[1], L[2], L[3], H[0], H[1], H[2], H[3]}
  od = __builtin_amdgcn_mfma_f32_32x32x16_bf16(pa0, PK(l0, h0), od, 0, 0, 0);
  od = __builtin_amdgcn_mfma_f32_32x32x16_bf16(pa1, PK(l1, h1), od, 0, 0, 0);
  od = __builtin_amdgcn_mfma_f32_32x32x16_bf16(pa2, PK(l2, h2), od, 0, 0, 0);
  od = __builtin_amdgcn_mfma_f32_32x32x16_bf16(pa3, PK(l3, h3), od, 0, 0, 0);
#undef PK
}
__device__ __forceinline__ void pv_d0(f32x16* o, int vb, bf16x8 pa0, bf16x8 pa1, bf16x8 pa2, bf16x8 pa3) {
  pv_one<0>(o[0], vb, pa0, pa1, pa2, pa3); pv_one<1>(o[1], vb, pa0, pa1, pa2, pa3); pv_one<2>(o[2], vb, pa0, pa1, pa2, pa3); pv_one<3>(o[3], vb, pa0, pa1, pa2, pa3);
}

}
struct Args { const float* in[NIN]; float* out; unsigned char* ws; int ph_lo, ph_hi; };

#define PIN(i) (A.in[(i)])
#define WSA(T, off) ((T*)(A.ws + (off)))
#define LDS_WAIT() asm volatile("s_waitcnt lgkmcnt(0)" ::: "memory")

__device__ __forceinline__ float bfv(const u32x4& a, int i) { const unsigned w = a[i >> 1]; return (i & 1) ? bfhi(w) : bflo(w); }
__device__ __forceinline__ float silu_f(float x) { return x / (1.f + expf(-x)); }

__device__ __forceinline__ float block_sum(const Ctx& C, float v) {
    v = wave_sum(v); LAS float* red = (LAS float*)(C.lds + LDS_RED);
    __syncthreads(); if (C.lane == 0) red[C.wave] = v; __syncthreads();
    float s = 0.f;
#pragma unroll
    for (int w = 0; w < 8; ++w) s += red[w];
    return s;
}

__device__ __forceinline__ size_t tiled_off(int n, int k, int K) { return ((size_t)(n >> 8) * (K >> 6) + (k >> 6)) * 16384 + (size_t)((n & 255) * 64 + (k & 63)); }
__device__ __forceinline__ void transpose_item(const float* W, int K, int N, bf16* WT, LAS float* scr, int item, int lane) {
    const int nblk = N / 32, kb = item / nblk, nb = item % nblk, k0 = 64 * kb, n0 = 32 * nb;
#pragma unroll
    for (int i = 0; i < 8; ++i) { const int kk = 8 * i + (lane >> 3), nn = (lane & 7) * 4; const f32x4 v = *(const f32x4*)(W + (size_t)(k0 + kk) * N + n0 + nn);
        scr[kk * 33 + nn] = v.x; scr[kk * 33 + nn + 1] = v.y; scr[kk * 33 + nn + 2] = v.z; scr[kk * 33 + nn + 3] = v.w; }
    LDS_WAIT();
    const int c = lane & 7;
#pragma unroll
    for (int j = 0; j < 4; ++j) { const int n = (lane >> 3) + 8 * j; const LAS float* s = scr + (8 * c) * 33 + n;
        u32x4 o; o.x = pk2(s[0 * 33], s[1 * 33]); o.y = pk2(s[2 * 33], s[3 * 33]); o.z = pk2(s[4 * 33], s[5 * 33]); o.w = pk2(s[6 * 33], s[7 * 33]);
        *(u32x4*)(WT + tiled_off(n0 + n, k0 + 8 * c, K)) = o; }
    LDS_WAIT();
}
__device__ __forceinline__ void ph_pro_a(const Ctx& C, const Args& A) {
    LAS float* scr = (LAS float*)(C.lds + C.wave * 16384);
    const int gw = C.bid * 8 + C.wave, NGW = C.G * 8;
    constexpr int I_IN = (DM / 64) * (INW / 32), I_OUT = (DM / 64) * (DM / 32), I_UP = (DM / 64) * (MLPH / 32), I_DN = (MLPH / 64) * (DM / 32), I_L = I_IN + I_OUT + I_UP + I_DN;
    for (int it = gw; it < DEPTH * I_L; it += NGW) {
        const int l = it / I_L; int r = it % I_L; unsigned char* wl = A.ws + WS_WT + (size_t)l * WT_LAYER;
        if (r < I_IN) { transpose_item(PIN(I_WIN) + (size_t)l * DM * INW, DM, INW, (bf16*)(wl + WT_IN), scr, r, C.lane); continue; } r -= I_IN;
        if (r < I_OUT) { transpose_item(PIN(I_WOUT) + (size_t)l * DM * DM, DM, DM, (bf16*)(wl + WT_OUT), scr, r, C.lane); continue; } r -= I_OUT;
        if (r < I_UP) { transpose_item(PIN(I_WUP) + (size_t)l * DM * MLPH, DM, MLPH, (bf16*)(wl + WT_UP), scr, r, C.lane); continue; } r -= I_UP;
        transpose_item(PIN(I_WDOWN) + (size_t)l * MLPH * DM, MLPH, DM, (bf16*)(wl + WT_DOWN), scr, r, C.lane);
    }
    const int gt = C.bid * 512 + C.tid, NT = C.G * 512;
    for (int idx = gt; idx < DEPTH * 32768; idx += NT) {
        const int l = idx >> 15, rem = idx & 32767, nrow = rem >> 6, k8 = (rem & 63) * 8, g = nrow >> 7, d = nrow & 127, gk = k8 >> 7, c0 = k8 & 127;
        u32x4 o = (u32x4){0u, 0u, 0u, 0u};
        if (g == gk) { const float* w = PIN(I_POOLW) + ((size_t)(l * 4 + g) * 128 + c0) * 128 + d;
            o.x = pk2(w[0], w[128]); o.y = pk2(w[256], w[384]); o.z = pk2(w[512], w[640]); o.w = pk2(w[768], w[896]); }
        *(u32x4*)((bf16*)(A.ws + WS_WT + (size_t)l * WT_LAYER + WT_POOL) + tiled_off(nrow, k8, 512)) = o;
    }
    { const float* cin = PIN(I_C); const float* cctx = PIN(I_CCTX); const float* wmod = PIN(I_WMOD); float* modp = WSA(float, WS_MODP);
      for (int it = gw; it < DEPTH * 48 * 32; it += NGW) {
        const int l = it / 1536, rem = it % 1536, cg = rem >> 5, kc = rem & 31, col = cg * 256 + C.lane * 4, k = kc * 64 + C.lane;
        const float a0 = silu_f(cin[k]), a1 = silu_f(cin[DM + k]), a2 = silu_f(cctx[k]);
        f32x4 s0 = (f32x4){0.f, 0.f, 0.f, 0.f}, s1 = s0, s2 = s0; const float* wp = wmod + ((size_t)l * DM + kc * 64) * MODW + col;
#pragma unroll 8
        for (int kk = 0; kk < 64; ++kk) { const f32x4 w = *(const f32x4*)(wp + (size_t)kk * MODW);
            const float b0 = __shfl(a0, kk), b1 = __shfl(a1, kk), b2 = __shfl(a2, kk); s0 += w * b0; s1 += w * b1; s2 += w * b2; }
        float* o = modp + ((size_t)(l * 32 + kc) * 3) * MODW + col; *(f32x4*)o = s0; *(f32x4*)(o + MODW) = s1; *(f32x4*)(o + 2 * MODW) = s2;
      } }
    for (int idx = gt; idx < 256 * 32; idx += NT) { const int pos = idx >> 5, i = idx & 31; const float invf = powf(10000.0f, -(float)i / 32.0f), ang = (float)pos * invf;
        WSA(cf32, WS_ROPE)[idx] = make_cf32(cosf(ang), sinf(ang)); }
    for (int idx = gt; idx < FFT_TWN; idx += NT) { const int L = idx < FFT_TW1 ? 16384 : (idx < FFT_TW2 ? 1024 : 64), S = L / 16, r = idx - (idx < FFT_TW1 ? FFT_TW0 : (idx < FFT_TW2 ? FFT_TW1 : FFT_TW2));
        const int q = r / S + 1, j = r % S; const float x = -2.0f * (float)(j * q) / (float)L; WSA(cf32, WS_TW)[idx] = make_cf32(cospif(x), sinpif(x)); }
}
__device__ __forceinline__ void ph_pro_b(const Ctx& C, const Args& A) {
    const int gt = C.bid * 512 + C.tid, NT = C.G * 512; const float* modp = WSA(float, WS_MODP); float* mod = WSA(float, WS_MOD);
    for (int idx = gt; idx < DEPTH * 3 * MODW; idx += NT) { const int l = idx / (3 * MODW), rem = idx % (3 * MODW), s = rem / MODW, col = rem % MODW; float acc = PIN(I_BMOD)[l * MODW + col];
#pragma unroll 8
        for (int kc = 0; kc < 32; ++kc) acc += modp[((size_t)(l * 32 + kc) * 3 + s) * MODW + col];
        mod[idx] = acc; }
}

template <bool SRC_F32, bool DST_F32>
__device__ __forceinline__ void ph_rownorm(const Ctx& C, const Args& A, bool upd, const float* gpost, const float* gate,
                                           bool do_hx, const float* gpre, const float* shp, const float* scp, int nrows, int nslices) {
    const int gw = C.bid * 8 + C.wave, NGW = C.G * 8;
    const bf16* OX = WSA(bf16, WS_OX); bf16* HX = WSA(bf16, WS_HX); bf16* XB = WSA(bf16, WS_XB);
    const int c0 = 8 * C.lane;
#pragma unroll 1
    for (int s = 0; s < 3; ++s) {
        if (s == 2 && (gw & 3)) continue;
        const int rstep = s < 2 ? NGW : (NGW >> 2);
        const int rbeg = s < 2 ? s * SEQ + gw : NLAT + (gw >> 2), rend = s < 2 ? (s + 1) * SEQ : nrows;
        if (rbeg >= rend) continue;
        f32x4 gg[8], aa[8], sh[8];
#pragma unroll
        for (int m = 0; m < 8; ++m) { const int col = c0 + 512 * (m >> 1) + 4 * (m & 1);
            gg[m] = upd ? *(const f32x4*)(gpost + col) * *(const f32x4*)(gate + s * MODW + col) : (f32x4){0.f, 0.f, 0.f, 0.f};
            aa[m] = do_hx ? *(const f32x4*)(gpre + col) * (*(const f32x4*)(scp + s * MODW + col) + 1.f) : (f32x4){0.f, 0.f, 0.f, 0.f};
            sh[m] = do_hx ? *(const f32x4*)(shp + s * MODW + col) : (f32x4){0.f, 0.f, 0.f, 0.f}; }
#pragma unroll 1
        for (int r = rbeg; r < rend; r += rstep) {
            f32x4 xv[8];
            if (SRC_F32) { const float* xs = (s < 2 ? PIN(I_X) + (size_t)r * DM : PIN(I_CTX) + (size_t)(r - NLAT) * DM) + c0;
#pragma unroll
                for (int m = 0; m < 8; ++m) xv[m] = *(const f32x4*)(xs + 512 * (m >> 1) + 4 * (m & 1)); }
            else {
#pragma unroll
                for (int j = 0; j < 4; ++j) { const u32x4 w = *(const u32x4*)(XB + (size_t)r * DM + c0 + 512 * j);
                    xv[2 * j] = (f32x4){bflo(w.x), bfhi(w.x), bflo(w.y), bfhi(w.y)}; xv[2 * j + 1] = (f32x4){bflo(w.z), bfhi(w.z), bflo(w.w), bfhi(w.w)}; } }
            if (upd) {
                f32x4 ov[8]; float ss = 0.f;
                if (s < 2) {
#pragma unroll
                    for (int j = 0; j < 4; ++j) { const u32x4 w = *(const u32x4*)(OX + (size_t)r * DM + c0 + 512 * j);
                        ov[2 * j] = (f32x4){bflo(w.x), bfhi(w.x), bflo(w.y), bfhi(w.y)}; ov[2 * j + 1] = (f32x4){bflo(w.z), bfhi(w.z), bflo(w.w), bfhi(w.w)}; }
                } else {
                    const float* pp = WSA(float, WS_PART) + (size_t)(r - NLAT) * DM + c0;
#pragma unroll
                    for (int m = 0; m < 8; ++m) ov[m] = (f32x4){0.f, 0.f, 0.f, 0.f};
#pragma unroll 1
                    for (int ks = 0; ks < nslices; ++ks) {
#pragma unroll
                        for (int m = 0; m < 8; ++m) ov[m] += *(const f32x4*)(pp + (size_t)ks * NCTX * DM + 512 * (m >> 1) + 4 * (m & 1)); }
                }
#pragma unroll
                for (int m = 0; m < 8; ++m) ss += (ov[m].x * ov[m].x + ov[m].y * ov[m].y) + (ov[m].z * ov[m].z + ov[m].w * ov[m].w);
                const float rstd = rsqrtf(wave_sum(ss) * (1.f / DM) + EPS);
#pragma unroll
                for (int m = 0; m < 8; ++m) xv[m] += gg[m] * (ov[m] * rstd);
                if (DST_F32) {
#pragma unroll
                    for (int m = 0; m < 8; ++m) *(f32x4*)(A.out + (size_t)r * DM + c0 + 512 * (m >> 1) + 4 * (m & 1)) = xv[m]; }
                else {
#pragma unroll
                    for (int j = 0; j < 4; ++j) { u32x4 w; w.x = pk2(xv[2 * j].x, xv[2 * j].y); w.y = pk2(xv[2 * j].z, xv[2 * j].w); w.z = pk2(xv[2 * j + 1].x, xv[2 * j + 1].y); w.w = pk2(xv[2 * j + 1].z, xv[2 * j + 1].w);
                        *(u32x4*)(XB + (size_t)r * DM + c0 + 512 * j) = w;
                        xv[2 * j] = (f32x4){bflo(w.x), bfhi(w.x), bflo(w.y), bfhi(w.y)}; xv[2 * j + 1] = (f32x4){bflo(w.z), bfhi(w.z), bflo(w.w), bfhi(w.w)}; } }
            }
            if (do_hx) {
                float ss = 0.f;
#pragma unroll
                for (int m = 0; m < 8; ++m) ss += (xv[m].x * xv[m].x + xv[m].y * xv[m].y) + (xv[m].z * xv[m].z + xv[m].w * xv[m].w);
                const float rstd = rsqrtf(wave_sum(ss) * (1.f / DM) + EPS);
#pragma unroll
                for (int j = 0; j < 4; ++j) { const f32x4 h0 = (xv[2 * j] * rstd) * aa[2 * j] + sh[2 * j], h1 = (xv[2 * j + 1] * rstd) * aa[2 * j + 1] + sh[2 * j + 1];
                    u32x4 w; w.x = pk2(h0.x, h0.y); w.y = pk2(h0.z, h0.w); w.z = pk2(h1.x, h1.y); w.w = pk2(h1.z, h1.w);
                    *(u32x4*)(HX + (size_t)r * DM + c0 + 512 * j) = w; }
            }
        }
    }
}

__device__ __forceinline__ void ph_filter_mlp(const Ctx& C, const Args& A, int l) {
    LAS float* feats = (LAS float*)C.lds;
    LAS float* h1 = feats + 65 * 36;
    LAS float* h2 = h1 + 65 * 64;
    const float* w1 = PIN(I_HW1) + l * 33 * 64; const float* b1 = PIN(I_HB1) + l * 64; const float* f1 = PIN(I_HF1) + l * 64;
    const float* w2 = PIN(I_HW2) + l * 64 * 64; const float* b2 = PIN(I_HB2) + l * 64; const float* f2 = PIN(I_HF2) + l * 64;
    const float* w3 = PIN(I_HW3) + (size_t)l * 64 * 1024; float* fpart = WSA(float, WS_FPART); float* HF = WSA(float, WS_HF); float* HFC = WSA(float, WS_HFC);
    for (int it = C.bid; it < 256; it += C.G) {
        const int i0 = it * 64;
#pragma unroll 1
        for (int idx = C.tid; idx < 65 * 33; idx += 512) { const int p = idx / 33, f = idx % 33, n = p < 64 ? SEQ : CTXL, i = p < 64 ? i0 + p : it; float val;
            if (f == 0) val = (float)i / (float)(n - 1);
            else { const int j = (f - 1) & 15; const float fj = 1e-4f + (float)j * ((15.0f - 1e-4f) / 15.0f), om = (6.283185307179586f * (float)i) / (float)n, a = fj * om;
                val = (f <= 16) ? cosf(a) : -sinf(a); }
            feats[p * 36 + f] = val; }
        __syncthreads();
        { const int u = fft_launder(C.tid & 63); float wc[33];
#pragma unroll
          for (int f = 0; f < 33; ++f) wc[f] = w1[f * 64 + u];
          const float bu = b1[u], fu = f1[u];
#pragma unroll 1
          for (int p = C.tid >> 6; p < 65; p += 8) { float acc = bu;
#pragma unroll
              for (int f = 0; f < 33; ++f) acc += feats[p * 36 + f] * wc[f];
              h1[p * 64 + u] = sinf(fu * acc); } }
        __syncthreads();
        { const int u = fft_launder(C.tid & 63); float wc[64];
#pragma unroll
          for (int k = 0; k < 64; ++k) wc[k] = w2[k * 64 + u];
          const float bu = b2[u], fu = f2[u];
#pragma unroll 1
          for (int p = C.tid >> 6; p < 65; p += 8) { float acc = bu;
#pragma unroll
              for (int k4 = 0; k4 < 16; ++k4) { const f32x4 hv = *(const LAS f32x4*)(h1 + p * 64 + 4 * k4);
                  acc += hv.x * wc[4 * k4] + hv.y * wc[4 * k4 + 1] + hv.z * wc[4 * k4 + 2] + hv.w * wc[4 * k4 + 3]; }
              h2[p * 64 + u] = sinf(fu * acc); } }
        __syncthreads();
        {
          const int c = fft_launder(C.tid); float wa[64], wb[64];
#pragma unroll
          for (int k = 0; k < 64; ++k) { wa[k] = w3[k * 1024 + c]; wb[k] = w3[k * 1024 + 512 + c]; }
          const float min_decay = -3.0701134573253945f, max_decay = -15.350567286626973f;
          const float delta = fabsf(min_decay + (float)c * ((max_decay - min_decay) / 511.0f)) * 1.4426950408889634f;
          float suma = 0.f, sumb = 0.f;
          LAS float* ot = h2 + 65 * 64;
#pragma unroll 1
          for (int pt = 0; pt < 64; pt += 16) {
#pragma unroll 1
              for (int pp = 0; pp < 16; ++pp) { const int p = pt + pp; float aa = 0.f, ab = 0.f;
#pragma unroll
                  for (int k4 = 0; k4 < 16; ++k4) { const f32x4 hv = *(const LAS f32x4*)(h2 + p * 64 + 4 * k4);
                      aa += hv.x * wa[4 * k4] + hv.y * wa[4 * k4 + 1] + hv.z * wa[4 * k4 + 2] + hv.w * wa[4 * k4 + 3];
                      ab += hv.x * wb[4 * k4] + hv.y * wb[4 * k4 + 1] + hv.z * wb[4 * k4 + 2] + hv.w * wb[4 * k4 + 3]; }
                  const float t = (float)(i0 + p) / (float)(SEQ - 1), dec = __builtin_amdgcn_exp2f(-t * delta); const float va = aa * dec, vb = ab * dec;
                  ot[c * 17 + pp] = va; ot[(512 + c) * 17 + pp] = vb; suma += fabsf(va); sumb += fabsf(vb); }
              __syncthreads();
#pragma unroll
              for (int q = 0; q < 8; ++q) { const int idx = C.tid + 512 * q, o = idx >> 2, qq = (idx & 3) * 4; const LAS float* s = ot + o * 17 + qq;
                  *(f32x4*)(HF + (size_t)o * SEQ + i0 + pt + qq) = (f32x4){s[0], s[1], s[2], s[3]}; }
              __syncthreads();
          }
          fpart[it * 1024 + c] = suma; fpart[it * 1024 + 512 + c] = sumb;
          { float aa = 0.f, ab = 0.f;
#pragma unroll
            for (int k4 = 0; k4 < 16; ++k4) { const f32x4 hv = *(const LAS f32x4*)(h2 + 64 * 64 + 4 * k4);
                aa += hv.x * wa[4 * k4] + hv.y * wa[4 * k4 + 1] + hv.z * wa[4 * k4 + 2] + hv.w * wa[4 * k4 + 3];
                ab += hv.x * wb[4 * k4] + hv.y * wb[4 * k4 + 1] + hv.z * wb[4 * k4 + 2] + hv.w * wb[4 * k4 + 3]; }
            const float t = (float)it / (float)(CTXL - 1), dec = __builtin_amdgcn_exp2f(-t * delta); const float va = aa * dec, vb = ab * dec;
            HFC[(size_t)c * CTXL + it] = va; HFC[(size_t)(512 + c) * CTXL + it] = vb;
            fpart[(256 + it) * 1024 + c] = fabsf(va); fpart[(256 + it) * 1024 + 512 + c] = fabsf(vb); } }
        __syncthreads();
    }
}
__device__ __forceinline__ int fft_freq_of(int p) { return (p >> 10) + 16 * ((p >> 6) & 15) + 256 * ((p >> 2) & 15) + 4096 * (p & 3); }
__device__ __forceinline__ int fft_pos_of(int f) { return 1024 * (f & 15) + 64 * ((f >> 4) & 15) + 4 * ((f >> 8) & 15) + (f >> 12); }
__device__ __forceinline__ void ph_filter_fft(const Ctx& C, const Args& A, int extra, int d) {
    LAS cf32* buf = (LAS cf32*)C.lds; const float* HF = WSA(float, WS_HF); const float* FP = WSA(float, WS_FPART); cf32* SPEC = WSA(cf32, WS_SPEC); const cf32* tw = WSA(cf32, WS_TW);
    const cf32 wstep = make_cf32(cospif(-1.0f / SEQ), sinpif(-1.0f / SEQ));
    constexpr int NIT = 512;
    const int nlow = C.G - extra, nA = (nlow * d < NIT) ? nlow * d : 0, dA = nA ? d : 0;
    const int myA = (C.bid >= extra) ? dA : 0, nB = NIT - nA, myB = (nB - C.bid + C.G - 1) / C.G > 0 ? (nB - C.bid + C.G - 1) / C.G : 0;
#pragma unroll 1
    for (int k = 0; k < myA + myB; ++k) {
        const int it = k < myA ? (C.bid - extra) + nlow * k : nA + C.bid + C.G * (k - myA);
        const int c0 = it >> 1, c1 = c0 + 256, e = it & 1;
        const float part0 = C.tid < 256 ? FP[C.tid * 1024 + c0] + FP[C.tid * 1024 + 512 + c0] : 0.f, part1 = C.tid < 256 ? FP[C.tid * 1024 + c1] + FP[C.tid * 1024 + 512 + c1] : 0.f;
        const float inv0 = 1.f / block_sum(C, part0), inv1 = 1.f / block_sum(C, part1);
        const float* hf0 = HF + (size_t)c0 * SEQ; const float* hb0 = HF + (size_t)(512 + c0) * SEQ; const float* hf1 = HF + (size_t)c1 * SEQ; const float* hb1 = HF + (size_t)(512 + c1) * SEQ;
#pragma unroll 2
        for (int q = 0; q < 8; ++q) { const int t0 = (C.tid + 512 * q) * 4; const f32x4 a0 = *(const f32x4*)(hf0 + t0), a1 = *(const f32x4*)(hf1 + t0);
            cf32 w = make_cf32(1.f, 0.f); if (e) { const float x = -(float)t0 * (1.0f / SEQ); w = make_cf32(cospif(x), sinpif(x)); }
#pragma unroll
            for (int i = 0; i < 4; ++i) { const int t = t0 + i, tb = (t == 0) ? 0 : SEQ - t; const float b0 = hb0[tb], b1 = hb1[tb]; cf32 v;
                if (e == 0 || t == 0) v = make_cf32((a0[i] + b0) * inv0, (a1[i] + b1) * inv1); else v = cmul(make_cf32((a0[i] - b0) * inv0, (a1[i] - b1) * inv1), w);
                buf[fpad(t)] = v; if (e) w = cmul(w, wstep); } }
        __syncthreads();
        FFT_FORWARD(buf, C.tid, tw);
        cf32* sp0 = SPEC + (size_t)(c0 * 2 + e) * SEQ; cf32* sp1 = SPEC + (size_t)(c1 * 2 + e) * SEQ;
#pragma unroll 2
        for (int q = 0; q < 16; ++q) { const int p0 = (C.tid + 512 * q) * 2; f32x4 o0, o1;
#pragma unroll
            for (int i = 0; i < 2; ++i) { const int p = p0 + i, f = fft_freq_of(p), fm = e ? (SEQ - 1 - f) : ((SEQ - f) & (SEQ - 1)), pm = fft_pos_of(fm);
                const cf32 zf = buf[fpad(p)], zm = buf[fpad(pm)], zc = make_cf32(zm.x, -zm.y), ka = (zf + zc) * 0.5f, dd = (zf - zc) * 0.5f;
                o0[2 * i] = ka.x; o0[2 * i + 1] = ka.y; o1[2 * i] = dd.y; o1[2 * i + 1] = -dd.x; }
            *(f32x4*)(sp0 + p0) = o0; *(f32x4*)(sp1 + p0) = o1; }
        __syncthreads();
    }
}
template <int E, int VAR = 0> __device__ __forceinline__ void conv_half(const Ctx& C, LAS cf32* buf, const bf16* v0, const bf16* v1, const cf32* sp, const cf32* tw, cf32 (&ya)[32], float* y0, float* y1) {
    const int tidl = fft_launder(C.tid);
    const cf32 wstep = make_cf32(cospif(-1.0f / SEQ), sinpif(-1.0f / SEQ));
#pragma unroll 1
    for (int k = 0; k < 4; ++k) { const int t0 = (tidl + 512 * k) * 8; const u32x4 a = *(const u32x4*)(v0 + t0), b = *(const u32x4*)(v1 + t0);
        cf32 w = make_cf32(1.f, 0.f); if (E) { const float x = -(float)t0 * (1.0f / SEQ); w = make_cf32(cospif(x), sinpif(x)); }
#pragma unroll
        for (int i = 0; i < 8; ++i) { cf32 z = make_cf32(bfv(a, i), bfv(b, i)); if (E) { z = cmul(z, w); w = cmul(w, wstep); } buf[fpad(t0 + i)] = z; } }
    __syncthreads();
    if (VAR != 1) { fft_pass16<16384, false>(buf, FFT_LAUNDER(tidl), tw); FFT_SYNC(); fft_pass16<1024, false>(buf, FFT_LAUNDER(tidl), tw); FFT_SYNC(); fft_pass16<64, false>(buf, FFT_LAUNDER(tidl), tw); FFT_SYNC(); }
#pragma unroll 2
    for (int k = 0; k < 8; ++k) { const int p0 = (tidl + 512 * k) * 4, b0 = fpad(p0); const f32x4 s0 = *(const f32x4*)(sp + p0), s1 = *(const f32x4*)(sp + p0 + 2);
        cf32 a = buf[b0], b = buf[b0 + 1], c = buf[b0 + 2], d = buf[b0 + 3];
        dft4<false>(a, b, c, d);
        a = cmul(a, make_cf32(s0.x, s0.y)); b = cmul(b, make_cf32(s0.z, s0.w)); c = cmul(c, make_cf32(s1.x, s1.y)); d = cmul(d, make_cf32(s1.z, s1.w));
        dft4<true>(a, b, c, d);
        buf[b0] = a; buf[b0 + 1] = b; buf[b0 + 2] = c; buf[b0 + 3] = d; }
    FFT_SYNC();
    if (VAR != 1) { fft_pass16<64, true>(buf, FFT_LAUNDER(tidl), tw); FFT_SYNC(); fft_pass16<1024, true>(buf, FFT_LAUNDER(tidl), tw); FFT_SYNC(); fft_pass16<16384, true>(buf, FFT_LAUNDER(tidl), tw); FFT_SYNC(); }
    if (E == 0) {
#pragma unroll
        for (int k = 0; k < 8; ++k) { const int t0 = (tidl + 512 * k) * 4;
#pragma unroll
            for (int i = 0; i < 4; ++i) ya[4 * k + i] = buf[fpad(t0 + i)]; } }
    else {
        const cf32 wstepc = make_cf32(wstep.x, -wstep.y);
#pragma unroll
        for (int k = 0; k < 8; ++k) { const int t0 = (tidl + 512 * k) * 4; const float x = (float)t0 * (1.0f / SEQ); cf32 w = make_cf32(cospif(x), sinpif(x));
            f32x4 o0, o1; const float sc = 1.0f / (2 * SEQ);
#pragma unroll
            for (int i = 0; i < 4; ++i) { const cf32 yb = cmul(buf[fpad(t0 + i)], w); w = cmul(w, wstepc); o0[i] = (ya[4 * k + i].x + yb.x) * sc; o1[i] = (ya[4 * k + i].y + yb.y) * sc; }
            *(f32x4*)(y0 + t0) = o0; *(f32x4*)(y1 + t0) = o1; asm volatile("" ::: "memory"); } }
    __syncthreads();
}
template <int VAR = 0> __device__ __forceinline__ void ph_conv(const Ctx& C, const Args& A) {
    LAS cf32* buf = (LAS cf32*)C.lds; const bf16* VT = WSA(bf16, WS_VT); float* YT = WSA(float, WS_YT); const cf32* SPEC = WSA(cf32, WS_SPEC); const cf32* tw = WSA(cf32, WS_TW);
#pragma unroll 1
    for (int c = C.bid; c < HYW; c += C.G) {
        const bf16* v0 = VT + (size_t)c * MROWS; const bf16* v1 = v0 + SEQ; float* y0 = YT + (size_t)c * MROWS; cf32 ya[32];
        conv_half<0, VAR>(C, buf, v0, v1, SPEC + (size_t)(c * 2) * SEQ, tw, ya, y0, y0 + SEQ);
        conv_half<1, VAR>(C, buf, v0, v1, SPEC + (size_t)(c * 2 + 1) * SEQ, tw, ya, y0, y0 + SEQ);
    }
}
__device__ __forceinline__ void ph_conv_ctx(const Ctx& C, const Args& A) {
    LAS float* taps = (LAS float*)C.lds; LAS float* vb = taps + 512;
    const float* HFC = WSA(float, WS_HFC); const float* FP = WSA(float, WS_FPART); const bf16* VT = WSA(bf16, WS_VT); float* YT = WSA(float, WS_YT);
    for (int c = C.bid; c < HYW; c += C.G) {
        const float part = C.tid < 256 ? FP[(256 + C.tid) * 1024 + c] + FP[(256 + C.tid) * 1024 + 512 + c] : 0.f;
        const float inv = 1.f / block_sum(C, part);
        if (C.tid < 511) { const int d = C.tid - 255; const float k = d > 0 ? HFC[(size_t)c * CTXL + d] : (d < 0 ? HFC[(size_t)(512 + c) * CTXL - d] : HFC[(size_t)c * CTXL] + HFC[(size_t)(512 + c) * CTXL]);
            taps[C.tid] = k * inv; }
        vb[C.tid] = bf2f(VT[(size_t)c * MROWS + NLAT + C.tid]);
        __syncthreads();
        const int b = C.tid >> 8, t = C.tid & 255; float acc = 0.f;
#pragma unroll 8
        for (int s = 0; s < CTXL; ++s) acc += taps[t - s + 255] * vb[b * CTXL + s];
        YT[(size_t)c * MROWS + NLAT + C.tid] = acc;
        __syncthreads();
    }
}

__device__ __forceinline__ void seq_of_row(int r, int& seq0, int& seqlen) { if (r < NLAT) { seq0 = r & ~(SEQ - 1); seqlen = SEQ; } else { seq0 = NLAT + ((r - NLAT) & ~(CTXL - 1)); seqlen = CTXL; } }
__device__ __forceinline__ void ph_krope(const Ctx& C, const Args& A) {
    const int gt = C.bid * 512 + C.tid, NT = C.G * 512; bf16* PX = WSA(bf16, WS_PX); const cf32* ROPE = WSA(cf32, WS_ROPE);
    for (int idx = gt; idx < NLAT * 16; idx += NT) { const int r = idx >> 4, sub = idx & 15, kvh = sub >> 3, half = (sub >> 2) & 1, q = sub & 3, t = r & (SEQ - 1), pos = half ? (t & 63) : (t >> 6);
        bf16* p = PX + (size_t)r * INW + Q_END + kvh * 128 + half * 64 + q * 8; const u32x4 a = *(const u32x4*)p, b = *(const u32x4*)(p + 32); const cf32* rt = ROPE + pos * 32 + q * 8;
        float n1[8], n2[8];
#pragma unroll
        for (int i = 0; i < 8; ++i) { const float x1 = bfv(a, i), x2 = bfv(b, i); const cf32 cs = rt[i]; n1[i] = x1 * cs.x - x2 * cs.y; n2[i] = x2 * cs.x + x1 * cs.y; }
        u32x4 oa, ob; oa.x = pk2(n1[0], n1[1]); oa.y = pk2(n1[2], n1[3]); oa.z = pk2(n1[4], n1[5]); oa.w = pk2(n1[6], n1[7]);
        ob.x = pk2(n2[0], n2[1]); ob.y = pk2(n2[2], n2[3]); ob.z = pk2(n2[4], n2[5]); ob.w = pk2(n2[6], n2[7]);
        *(u32x4*)p = oa; *(u32x4*)(p + 32) = ob; }
}
__device__ __forceinline__ void ph_hyena_pre(const Ctx& C, const Args& A, int l, int nrows) {
    LAS unsigned short* tile = (LAS unsigned short*)C.lds;
    const bf16* PX = WSA(bf16, WS_PX); bf16* VT = WSA(bf16, WS_VT);
    const float* cw = PIN(I_HCW) + l * 3 * 1536; const float* cb = PIN(I_HCB) + l * 1536;
    const int ct = C.bid & 7, c8 = (C.tid & 7) * 8, ch = ct * 64 + c8, tt = C.tid >> 3;
    float wx[3][8], wv[3][8], bx[8], bv[8];
#pragma unroll
    for (int i = 0; i < 8; ++i) { bx[i] = cb[512 + ch + i]; bv[i] = cb[1024 + ch + i];
#pragma unroll
        for (int d = 0; d < 3; ++d) { wx[d][i] = cw[d * 1536 + 512 + ch + i]; wv[d][i] = cw[d * 1536 + 1024 + ch + i]; } }
    u32x4 ra[3], rb[3], na[3], nb[3];
#define HP_LOAD(TL, DA, DB) do { const int r0_ = (TL) * 64; int s0_, sl_; seq_of_row(r0_, s0_, sl_); const int r_ = r0_ + tt, tin_ = r_ - s0_; \
        _Pragma("unroll") for (int d = 0; d < 3; ++d) { const bool ok_ = (tin_ + d - 1 >= 0) && (tin_ + d - 1 < sl_); const bf16* p_ = PX + (size_t)(r_ + d - 1) * INW + V_END + ch; \
            DA[d] = ok_ ? *(const u32x4*)(p_ + 512) : (u32x4){0u, 0u, 0u, 0u}; DB[d] = ok_ ? *(const u32x4*)(p_ + 1024) : (u32x4){0u, 0u, 0u, 0u}; } } while (0)
    int tl = C.bid >> 3; const int tstep = C.G >> 3;
    const int ntl = nrows / 64;
    if (tl < ntl) HP_LOAD(tl, ra, rb);
#pragma unroll 1
    for (; tl < ntl; tl += tstep) {
        const int r0 = tl * 64;
        if (tl + tstep < ntl) HP_LOAD(tl + tstep, na, nb);
        float x1[8], vv[8];
#pragma unroll
        for (int i = 0; i < 8; ++i) { x1[i] = bx[i]; vv[i] = bv[i]; }
#pragma unroll
        for (int d = 0; d < 3; ++d) {
#pragma unroll
            for (int i = 0; i < 8; ++i) { x1[i] += bfv(ra[d], i) * wx[d][i]; vv[i] += bfv(rb[d], i) * wv[d][i]; } }
#pragma unroll
        for (int i = 0; i < 8; ++i) tile[(c8 + i) * 72 + tt] = (unsigned short)f2bf(x1[i] * vv[i]);
        __syncthreads();
        const int cc = C.tid >> 3, t8 = (C.tid & 7) * 8;
        const u32x4 o = *(const LAS u32x4*)(tile + cc * 72 + t8);
        *(u32x4*)(VT + (size_t)(ct * 64 + cc) * MROWS + r0 + t8) = o;
        __syncthreads();
#pragma unroll
        for (int d = 0; d < 3; ++d) { ra[d] = na[d]; rb[d] = nb[d]; }
    }
#undef HP_LOAD
}
__device__ __forceinline__ void ph_pool_pre(const Ctx& C, const Args& A, int nrows) {
    LAS u32x4* st = (LAS u32x4*)C.lds;
    const bf16* PX = WSA(bf16, WS_PX); bf16* PO = WSA(bf16, WS_POOLED);
    for (int tl = C.bid; tl < NLAT / 64; tl += C.G) {
        const int r0 = tl * 64; int seq0, seqlen; seq_of_row(r0, seq0, seqlen); const int tin0 = r0 - seq0;
#pragma unroll
        for (int k = 0; k < 10; ++k) { const int idx = C.tid + 512 * k, rr = idx >> 6, ck = idx & 63, tin = tin0 - 8 + rr;
            st[idx] = (tin >= 0 && tin < seqlen) ? *(const u32x4*)(PX + (size_t)(seq0 + tin) * INW + HY_END + ck * 8) : (u32x4){0u, 0u, 0u, 0u}; }
        __syncthreads();
#pragma unroll 1
        for (int k = 0; k < 8; ++k) { const int idx = C.tid + 512 * k, tt = idx >> 6, ck = idx & 63, g = ck >> 4, h = 1 << g, tin = tin0 + tt;
            float s[8];
#pragma unroll
            for (int i = 0; i < 8; ++i) s[i] = 0.f;
            for (int q = tt + 8 - h; q < tt + 8 + h; ++q) { const u32x4 a = st[q * 64 + ck];
#pragma unroll
                for (int i = 0; i < 8; ++i) s[i] += bfv(a, i); }
            const u32x4 xs = st[(tt + 8) * 64 + ck]; const int lo = tin - h > 0 ? tin - h : 0, hi = tin + h < seqlen ? tin + h : seqlen; const float invc = 1.f / (float)(hi - lo); float o[8];
#pragma unroll
            for (int i = 0; i < 8; ++i) o[i] = s[i] * invc - bfv(xs, i);
            u32x4 w; w.x = pk2(o[0], o[1]); w.y = pk2(o[2], o[3]); w.z = pk2(o[4], o[5]); w.w = pk2(o[6], o[7]);
            *(u32x4*)(PO + (size_t)(r0 + tt) * 512 + ck * 8) = w; }
        __syncthreads();
    }
    if (nrows > NLAT) {
        const int rpb = (MROWS - NLAT + C.G - 1) / C.G;
        for (int idx = C.tid; idx < rpb * 64; idx += 512) { const int rr = C.bid * rpb + (idx >> 6); if (rr >= MROWS - NLAT) break;
            const int r = NLAT + rr, ck = idx & 63, h = 1 << (ck >> 4); int seq0, seqlen; seq_of_row(r, seq0, seqlen);
            const int tin = r - seq0, lo = tin - h > 0 ? tin - h : 0, hi = tin + h < seqlen ? tin + h : seqlen;
            const bf16* base = PX + (size_t)seq0 * INW + HY_END + ck * 8;
            float s[8];
#pragma unroll
            for (int i = 0; i < 8; ++i) s[i] = 0.f;
#pragma unroll 4
            for (int q = lo; q < hi; ++q) { const u32x4 a = *(const u32x4*)(base + (size_t)q * INW);
#pragma unroll
                for (int i = 0; i < 8; ++i) s[i] += bfv(a, i); }
            const u32x4 xs = *(const u32x4*)(base + (size_t)tin * INW); const float invc = 1.f / (float)(hi - lo); float o[8];
#pragma unroll
            for (int i = 0; i < 8; ++i) o[i] = s[i] * invc - bfv(xs, i);
            u32x4 w; w.x = pk2(o[0], o[1]); w.y = pk2(o[2], o[3]); w.z = pk2(o[4], o[5]); w.w = pk2(o[6], o[7]);
            *(u32x4*)(PO + (size_t)r * 512 + ck * 8) = w; }
    }
}
__device__ __forceinline__ void ph_attention(const Ctx& C, const Args& A, int l, bool do_ctx) {
    using namespace att;
    const bf16* PX = WSA(bf16, WS_PX); bf16* MG = WSA(bf16, WS_MERGED); const cf32* ROPE = WSA(cf32, WS_ROPE);
    char* LB = C.ldsg; float* wsf = (float*)(C.ldsg + 131072) + C.wave * 64; float* li_l = wsf; float* al_l = wsf + 32;
    const int tid = C.tid, lane = C.lane, wid = C.wave, r32 = lane & 31, hi = lane >> 5;
    const int sr = tid >> 4, sc = (tid & 15) * 8, vst0 = v_st(sr, sc), vst1 = v_st(32 + sr, sc);
    const int vbase = (int)(uintptr_t)LB + v_rd_base(lane);
    unsigned doff[8];
#pragma unroll
    for (int q = 0; q < 8; ++q) { const int pc = wid + 8 * q, region = pc >> 4, ob = (pc & 15) * 1024 + lane * 16;
        int key, col;
        if (region >= 2) { const int row = ob >> 8; key = (region & 1) * 64 + row; col = ((ob & 255) ^ ((row & 7) << 4)) >> 1; }
        else { const int sub = ob >> 9, e = (ob & 511) >> 1, kk = (sub >> 2) * 8 + (e >> 5), k = (kk & ~0xC) | ((kk & 4) << 1) | ((kk & 8) >> 1); key = (region & 1) * 64 + k; col = 256 + (sub & 3) * 32 + (e & 31); }
        doff[q] = (unsigned)(key * INW + col) * 2u; }
    const int nlat_u = (1024 - C.bid + C.G - 1) / C.G, nctx_u = (do_ctx && C.bid >= C.G - 16) ? 1 : 0;
#pragma unroll 1
    for (int ui = 0; ui < nlat_u + nctx_u; ++ui) {
        const int unit = ui < nlat_u ? 16 + C.bid + C.G * ui : C.G - 1 - C.bid;
        bool isctx; int b, qb, kvh, hp;
        if (unit < 16) { isctx = true; b = unit >> 3; kvh = (unit >> 2) & 1; hp = (unit >> 1) & 1; qb = unit & 1; }
        else { const int u = unit - 16; isctx = false; hp = u & 1; kvh = (u >> 1) & 1; qb = (u >> 2) & 127; b = u >> 9; }
        const int hq = kvh * 4 + hp * 2 + (wid >> 2), t = qb * 128 + (wid & 3) * 32 + r32;
        const size_t seqrow0 = isctx ? (size_t)(NLAT + b * CTXL) : (size_t)b * SEQ;
        const size_t ctxrow0 = (size_t)(NLAT + b * CTXL);
        bf16x8 qr[8];
        { const bf16* qp = PX + (seqrow0 + t) * INW + hq * 128 + hi * 8;
#pragma unroll
          for (int d0 = 0; d0 < 8; ++d0) qr[d0] = *(const bf16x8*)(qp + d0 * 16);
          if (!isctx) {
#pragma unroll
            for (int hf = 0; hf < 2; ++hf) { const int pos = hf ? (t & 63) : (t >> 6);
#pragma unroll
                for (int dd = 0; dd < 2; ++dd) { const int d0 = hf * 4 + dd; const cf32* rt = ROPE + pos * 32 + dd * 16 + hi * 8; bf16x8 a = qr[d0], bq = qr[d0 + 2];
#pragma unroll
                    for (int j = 0; j < 8; ++j) { const float x1 = bf2f((unsigned short)a[j]), x2 = bf2f((unsigned short)bq[j]); const cf32 cs = rt[j];
                        a[j] = (short)f2bf(x1 * cs.x - x2 * cs.y); bq[j] = (short)f2bf(x2 * cs.x + x1 * cs.y); }
                    qr[d0] = a; qr[d0 + 2] = bq; } } } }
        float m_reg = PIN(I_SINK)[l * 8 + hq] * (1.0f / SCALE), l_reg = 1.f; f32x16 o[4] = {};
        const int blo = isctx ? 0 : (qb == 0 ? 1 : 0), bhi = isctx ? 0 : (qb == SEQ / 128 - 1 ? 2 : 3), nband = bhi - blo, nst = nband + 2;
#define ATT_BASE(i) ((const char*)(PX + ((i) < nband ? seqrow0 + (size_t)(128 * (qb - 1 + blo + (i))) : ctxrow0 + (size_t)(128 * ((i) - nband))) * INW + Q_END + kvh * 128))
#define ATT_DMA(i) do { const char* gb_ = ATT_BASE(i); LAS unsigned char* lb_ = C.lds + ((i) & 1) * 65536 + wid * 1024; \
        _Pragma("unroll") for (int q_ = 0; q_ < 8; ++q_) __builtin_amdgcn_global_load_lds((const unsigned*)(gb_ + doff[q_]), (LAS unsigned*)(lb_ + q_ * 8192), 16, 0, 0); } while (0)
        __syncthreads();
        ATT_DMA(0);
#pragma unroll 1
        for (int i = 0; i < nst; ++i) {
            char* buf = LB + (i & 1) * 65536;
            asm volatile("s_waitcnt vmcnt(0)" ::: "memory"); __syncthreads();
            if (i + 1 < nst) ATT_DMA(i + 1);
            const int blk = blo + i; const bool masked = (i < nband) && (blk != 1);
#pragma unroll 1
            for (int hh = 0; hh < 2; ++hh) {
                const int s0 = 128 * (qb - 1 + blk) + 64 * hh;
                if (masked && ((blk == 0 && hh == 0 && (wid & 3) >= 2) || (blk == 2 && hh == 1 && (wid & 3) < 2))) continue;
                f32x16 p0, p1; qkt(p0, p1, buf + 32768 + hh * 16384, qr, r32, hi);
                if (masked) {
                    const bool prev = (blk == 0); const int base = t - s0 - 4 * hi, u0 = prev ? base : -base;
#pragma unroll
                    for (int r = 0; r < 16; ++r) { const int cr = (r & 3) + 8 * (r >> 2); const int th0 = prev ? 128 + cr : 128 - cr, th1 = prev ? 160 + cr : 96 - cr;
                        if (u0 > th0) p0[r] = -1e30f; if (u0 > th1) p1[r] = -1e30f; }
                }
                float mn, alpha; partialSM(p0, p1, m_reg, mn, alpha);
                if (__any(alpha < 1.f)) { if (hi == 0) al_l[r32] = alpha; asm volatile("s_waitcnt lgkmcnt(0)" ::: "memory");
#pragma unroll
                    for (int d = 0; d < 4; ++d)
#pragma unroll
                        for (int r = 0; r < 16; ++r) o[d][r] *= al_l[crow(r, hi)]; }
                bf16x8 pa0, pa1, pa2, pa3; finishSM(p0, p1, alpha, l_reg, pa0, pa1, pa2, pa3); SBAR();
                pv_d0(o, vbase + (i & 1) * 65536 + hh * 16384, pa0, pa1, pa2, pa3);
            }
        }
#undef ATT_BASE
#undef ATT_DMA
        if (hi == 0) li_l[r32] = l_reg; asm volatile("s_waitcnt lgkmcnt(0)" ::: "memory");
        { char* tb = LB + (nst & 1) * 65536 + wid * 8192;
#pragma unroll
          for (int r = 0; r < 16; ++r) { const int orow = crow(r, hi); const float rl = __builtin_amdgcn_rcpf(li_l[orow]);
#pragma unroll
              for (int d0 = 0; d0 < 4; ++d0) *(bf16*)(tb + orow * 256 + (d0 * 32 + r32) * 2) = (bf16)f2bf(o[d0][r] * rl); }
          asm volatile("s_waitcnt lgkmcnt(0)" ::: "memory");
          bf16* Ow = MG + (seqrow0 + qb * 128 + (wid & 3) * 32) * DM + hq * 128;
#pragma unroll
          for (int k = 0; k < 8; ++k) { const int q = lane + 64 * k, row = q >> 4, ch = q & 15;
              *(u32x4*)(Ow + (size_t)row * DM + ch * 8) = *(const u32x4*)(tb + row * 256 + ch * 16); } }
    }
    __syncthreads();
}

__device__ __forceinline__ void ph_mix_post(const Ctx& C, const Args& A, int l, bool do_attn, int nrows) {
    LAS float* ytile = (LAS float*)C.lds;
    LAS float* vtile = ytile + 32 * 516;
    const bf16* PX = WSA(bf16, WS_PX); bf16* MG = WSA(bf16, WS_MERGED); const bf16* PR = WSA(bf16, WS_PORAW); const bf16* VT = WSA(bf16, WS_VT); const float* YT = WSA(float, WS_YT);
    const float* cw = PIN(I_HCW) + l * 3 * 1536; const float* cb = PIN(I_HCB) + l * 1536; const float* hbias = PIN(I_HBIAS) + l * 512; const float* psc = PIN(I_POOLS) + l * 512; const float* gbr = PIN(I_GBRANCH) + l * DM;
    const int c0 = C.lane * 8;
    float r_cb[8], r_cw[3][8], r_hb[8], r_gh[8], r_ps[8], r_gp[8], r_ga[16];
#pragma unroll
    for (int i = 0; i < 8; ++i) { r_cb[i] = cb[c0 + i]; r_hb[i] = hbias[c0 + i]; r_gh[i] = gbr[1024 + c0 + i]; r_ps[i] = psc[c0 + i]; r_gp[i] = gbr[1536 + c0 + i];
        r_cw[0][i] = cw[c0 + i]; r_cw[1][i] = cw[1536 + c0 + i]; r_cw[2][i] = cw[3072 + c0 + i]; }
#pragma unroll
    for (int i = 0; i < 16; ++i) r_ga[i] = gbr[C.lane * 16 + i];
    auto token = [&](const int r0, const int seq0, const int seqlen, const int tt) __attribute__((always_inline)) {
            const int r = r0 + tt, tin = r - seq0;
            { float x0[8], hy[8];
#pragma unroll
              for (int i = 0; i < 8; ++i) x0[i] = r_cb[i];
#pragma unroll
              for (int dt = -1; dt <= 1; ++dt) { if (tin + dt < 0 || tin + dt >= seqlen) continue;
                  const u32x4 a = *(const u32x4*)(PX + (size_t)(r + dt) * INW + V_END + c0);
#pragma unroll
                  for (int i = 0; i < 8; ++i) x0[i] += bfv(a, i) * r_cw[dt + 1][i]; }
              const f32x4 ya = *(const LAS f32x4*)(ytile + tt * 516 + c0), yb = *(const LAS f32x4*)(ytile + tt * 516 + c0 + 4);
              const f32x4 va = *(const LAS f32x4*)(vtile + tt * 516 + c0), vb = *(const LAS f32x4*)(vtile + tt * 516 + c0 + 4);
              float ss = 0.f;
#pragma unroll
              for (int i = 0; i < 8; ++i) { const float y = i < 4 ? ya[i] : yb[i - 4], v = i < 4 ? va[i] : vb[i - 4]; hy[i] = (y + v * r_hb[i]) * x0[i]; ss += hy[i] * hy[i]; }
              const float rstd = rsqrtf(wave_sum(ss) * (1.f / HYW) + EPS); const float* g = r_gh;
              u32x4 w; w.x = pk2(hy[0] * rstd * g[0], hy[1] * rstd * g[1]); w.y = pk2(hy[2] * rstd * g[2], hy[3] * rstd * g[3]);
              w.z = pk2(hy[4] * rstd * g[4], hy[5] * rstd * g[5]); w.w = pk2(hy[6] * rstd * g[6], hy[7] * rstd * g[7]);
              *(u32x4*)(MG + (size_t)r * DM + 1024 + c0) = w; }
            { const u32x4 a = *(const u32x4*)(PR + (size_t)r * 512 + c0); float po[8]; float ss = 0.f;
#pragma unroll
              for (int i = 0; i < 8; ++i) { po[i] = bfv(a, i) * r_ps[i]; ss += po[i] * po[i]; }
              const float rstd = rsqrtf(wave_sum(ss) * (1.f / PLW) + EPS); const float* g = r_gp;
              u32x4 w; w.x = pk2(po[0] * rstd * g[0], po[1] * rstd * g[1]); w.y = pk2(po[2] * rstd * g[2], po[3] * rstd * g[3]);
              w.z = pk2(po[4] * rstd * g[4], po[5] * rstd * g[5]); w.w = pk2(po[6] * rstd * g[6], po[7] * rstd * g[7]);
              *(u32x4*)(MG + (size_t)r * DM + 1536 + c0) = w; }
            if (do_attn) { bf16* ap = MG + (size_t)r * DM + C.lane * 16; const u32x4 a = *(const u32x4*)ap, b = *(const u32x4*)(ap + 8); float av[16]; float ss = 0.f;
#pragma unroll
              for (int i = 0; i < 8; ++i) { av[i] = bfv(a, i); av[8 + i] = bfv(b, i); }
#pragma unroll
              for (int i = 0; i < 16; ++i) ss += av[i] * av[i];
              const float rstd = rsqrtf(wave_sum(ss) * (1.f / 1024.f) + EPS); const float* g = r_ga;
              u32x4 w0, w1; w0.x = pk2(av[0] * rstd * g[0], av[1] * rstd * g[1]); w0.y = pk2(av[2] * rstd * g[2], av[3] * rstd * g[3]);
              w0.z = pk2(av[4] * rstd * g[4], av[5] * rstd * g[5]); w0.w = pk2(av[6] * rstd * g[6], av[7] * rstd * g[7]);
              w1.x = pk2(av[8] * rstd * g[8], av[9] * rstd * g[9]); w1.y = pk2(av[10] * rstd * g[10], av[11] * rstd * g[11]);
              w1.z = pk2(av[12] * rstd * g[12], av[13] * rstd * g[13]); w1.w = pk2(av[14] * rstd * g[14], av[15] * rstd * g[15]);
              *(u32x4*)ap = w0; *(u32x4*)(ap + 8) = w1; }
    };
    for (int it = C.bid; it < NLAT / 32; it += C.G) {
        const int r0 = it * 32; int seq0, seqlen; seq_of_row(r0, seq0, seqlen);
#pragma unroll
        for (int k = 0; k < 8; ++k) { const int c = (C.tid >> 3) + 64 * k, t4 = (C.tid & 7) * 4; const f32x4 y = *(const f32x4*)(YT + (size_t)c * MROWS + r0 + t4);
            ytile[(t4 + 0) * 516 + c] = y.x; ytile[(t4 + 1) * 516 + c] = y.y; ytile[(t4 + 2) * 516 + c] = y.z; ytile[(t4 + 3) * 516 + c] = y.w; }
#pragma unroll
        for (int k = 0; k < 4; ++k) { const int c = (C.tid >> 2) + 128 * k, t8 = (C.tid & 3) * 8; const u32x4 v = *(const u32x4*)(VT + (size_t)c * MROWS + r0 + t8);
#pragma unroll
            for (int i = 0; i < 8; ++i) vtile[(t8 + i) * 516 + c] = bfv(v, i); }
        __syncthreads();
#pragma unroll 1
        for (int q = 0; q < 4; ++q) token(r0, seq0, seqlen, C.wave * 4 + q);
        __syncthreads();
    }
    if (nrows > NLAT && C.bid >= C.G / 2) {
        for (int m = C.bid - C.G / 2; m < (MROWS - NLAT) / 4; m += C.G / 2) {
            const int r0 = NLAT + m * 4; int seq0, seqlen; seq_of_row(r0, seq0, seqlen);
            { const int c = C.tid; const f32x4 y = *(const f32x4*)(YT + (size_t)c * MROWS + r0); const u32x2 v = *(const u32x2*)(VT + (size_t)c * MROWS + r0);
              ytile[0 * 516 + c] = y.x; ytile[1 * 516 + c] = y.y; ytile[2 * 516 + c] = y.z; ytile[3 * 516 + c] = y.w;
              vtile[0 * 516 + c] = bflo(v.x); vtile[1 * 516 + c] = bfhi(v.x); vtile[2 * 516 + c] = bflo(v.y); vtile[3 * 516 + c] = bfhi(v.y); }
            __syncthreads();
            if (C.wave < 4) token(r0, seq0, seqlen, C.wave);
            __syncthreads();
        }
    }
}
constexpr int NPHASES = 2 + 10 + 9 * (DEPTH - 1);
__device__ __forceinline__ Ctx fresh(const Ctx& C) { Ctx R = C; R.tid = fft_launder(C.tid); R.lane = R.tid & 63; return R; }
#define CL fresh(C)
#ifndef PROBE_GEMM
#define PROBE_GEMM 0
#endif
#ifndef PROBE_FFT
#define PROBE_FFT 0
#endif
#ifndef PROBE_MLP
#define PROBE_MLP 0
#endif
#ifndef PROBE_FFTF
#define PROBE_FFTF 0
#endif
#if PROBE_MLP
#define MLP_REP(...) __VA_ARGS__ __VA_ARGS__
#else
#define MLP_REP(...) __VA_ARGS__
#endif
#if PROBE_FFTF
#define FFTF_REP(...) __VA_ARGS__ __VA_ARGS__
#else
#define FFTF_REP(...) __VA_ARGS__
#endif
#ifndef PROBE_MP
#define PROBE_MP 0
#endif
#ifndef PROBE_RN
#define PROBE_RN 0
#endif
#if PROBE_MP
#define MP_REP(...) __VA_ARGS__
#else
#define MP_REP(...)
#endif
#if PROBE_RN
#define RN_REP(...) __VA_ARGS__
#else
#define RN_REP(...)
#endif
#ifndef WGM_DOWN
#define WGM_DOWN 4
#endif
#ifndef WGM_IN
#define WGM_IN 4
#endif
#ifndef WGM_OUT
#define WGM_OUT 4
#endif
#ifndef WGM_UP
#define WGM_UP 4
#endif
#ifndef PROBE_WIN
#define PROBE_WIN 0
#endif
#ifndef PROBE_GD0
#define PROBE_GD0 0
#endif
#ifndef PROBE_GU
#define PROBE_GU 0
#endif
#ifndef PROBE_GD
#define PROBE_GD 0
#endif
#if PROBE_GU || PROBE_GEMM
#define GEMMU_REP(...) __VA_ARGS__ __syncthreads(); __VA_ARGS__
#else
#define GEMMU_REP(...) __VA_ARGS__
#endif
#if PROBE_GD || PROBE_GEMM
#define GEMMD_REP(...) __VA_ARGS__ __syncthreads(); __VA_ARGS__
#else
#define GEMMD_REP(...) __VA_ARGS__
#endif
#ifndef PROBE_ATT
#define PROBE_ATT 0
#endif
#ifndef PROBE_PRE
#define PROBE_PRE 0
#endif
#if PROBE_GEMM
#define GEMM_REP(...) __VA_ARGS__ __syncthreads(); __VA_ARGS__
#else
#define GEMM_REP(...) __VA_ARGS__
#endif
#if PROBE_FFT
#define FFT_REP(...) __VA_ARGS__ __VA_ARGS__
#else
#define FFT_REP(...) __VA_ARGS__
#endif
#if PROBE_ATT
#define ATT_REP(...) __VA_ARGS__ __VA_ARGS__
#else
#define ATT_REP(...) __VA_ARGS__
#endif
#if PROBE_PRE
#define PRE_REP(...) __VA_ARGS__ __VA_ARGS__
#else
#define PRE_REP(...) __VA_ARGS__
#endif
#ifndef TPROBE
#define TPROBE 0
#endif
#if TPROBE
#define TP_TS ((unsigned long long*)(A.ws + WS_CTL + 131072))
#define TP_KIND(p) ((p) < 3 ? (p) : 3 + ((p) - 3) % 9)
#ifndef TP_SEL
#define TP_SEL(p) 1
#endif
#ifndef TP_MODE
#define TP_MODE 1
#endif
#ifndef TP_SCALE
#define TP_SCALE 4
#endif
#endif
__global__ void __launch_bounds__(512, 2) trunk_fwd(Args A) {
    extern __shared__ __attribute__((aligned(16))) unsigned char lds_raw[];
    Ctx C;
    C.lds = (LAS unsigned char*)lds_raw; C.ldsg = (char*)lds_raw;
    C.tid = threadIdx.x; C.lane = C.tid & 63; C.wave = __builtin_amdgcn_readfirstlane(C.tid >> 6); C.bid = blockIdx.x; C.G = gridDim.x;
    volatile LAS unsigned* MISC = (volatile LAS unsigned*)(C.lds + LDS_MISC);
    if (C.tid < 64) MISC[C.tid] = 0u;
    __syncthreads();
    unsigned* barw = (unsigned*)(A.ws + WS_CTL) + 4096;
    XcdBarrier bar; bar.bar = barw; bar.x = 0; bar.st = nullptr;
#if !MK_PER_PHASE
    bar = xcd_barrier_post(barw, MISC);
#endif
    const int lo = A.ph_lo, hi = A.ph_hi;
#if MK_PER_PHASE
#define PH_END(id) }
#elif TPROBE
#define PH_END(id) if (C.tid == 0) TP_TS[((id) + 1) * 256 + C.bid] = __builtin_amdgcn_s_memrealtime(); xcd_barrier(bar); }
#else
#define PH_END(id) if ((id) + 1 < hi) xcd_barrier(bar); }
#endif
#if TPROBE
    if (C.tid == 0) TP_TS[C.bid] = __builtin_amdgcn_s_memrealtime();
#endif
#define PH_BEGIN(id) if (lo <= (id) && (id) < hi) {
    const float* MOD = WSA(float, WS_MOD);
    PH_BEGIN(0) ph_pro_a(CL, A); PH_END(0)
    PH_BEGIN(1) ph_pro_b(CL, A); PH_END(1)
    int id = 2;
#pragma unroll 1
    for (int l = 0; l < DEPTH; ++l) {
        const float* modl = MOD + (size_t)l * 3 * MODW; const bool last = (l == DEPTH - 1); const int mrows = last ? NLAT : MROWS;
        unsigned char* wl = A.ws + WS_WT + (size_t)l * WT_LAYER;
        if (l == 0) {
            PH_BEGIN(id) MLP_REP(ph_filter_mlp(CL, A, 0);)
                ph_rownorm<true, false>(CL, A, false, nullptr, nullptr, true, PIN(I_GPREMIX), modl + 0 * DM, modl + 1 * DM, MROWS, 0); PH_END(id)
            ++id;
        }
        PH_BEGIN(id)
#if PROBE_WIN
            { pg8::Gemm g{WSA(bf16, WS_HX), (const bf16*)(wl + WT_IN), PROBE_WIN, INW, DM, DM, 0, 1}; pg8::RevOrder S; S.init(PROBE_WIN, INW, C.G, C.bid, WGM_IN);
              pg8::EpiOut<0> E{WSA(bf16, WS_PX), INW, 0}; pg8::gemm_phase<pg8::EpiOut<0>, pg8::RevOrder, true, true>(C.lds, g, S, E); } __syncthreads();
#endif
            GEMM_REP({ pg8::Gemm g{WSA(bf16, WS_HX), (const bf16*)(wl + WT_IN), MROWS, INW, DM, DM, 0, 1}; pg8::RevOrder S; S.init(MROWS, INW, C.G, C.bid, WGM_IN);
            pg8::EpiOut<0> E{WSA(bf16, WS_PX), INW, 0}; pg8::gemm_phase<pg8::EpiOut<0>, pg8::RevOrder, true, true>(C.lds, g, S, E); })
            FFTF_REP(ph_filter_fft(CL, A, ((MROWS / 256) * (INW / 256)) % C.G, 2);) PH_END(id)
        ++id;
        PH_BEGIN(id) ph_krope(CL, A); PRE_REP(ph_hyena_pre(CL, A, l, mrows); ph_pool_pre(CL, A, mrows);) PH_END(id)
        ++id;
        PH_BEGIN(id) FFT_REP(ph_conv<0>(CL, A); if (!last) ph_conv_ctx(CL, A);) ATT_REP(ph_attention(CL, A, l, !last);)
            GEMM_REP({ pg8::Gemm g{WSA(bf16, WS_POOLED), (const bf16*)(wl + WT_POOL), mrows, 512, 512, 512, 0, 1}; pg8::StaticOrder S; S.init(mrows, 512, C.G, C.bid);
              pg8::EpiOut<0> E{WSA(bf16, WS_PORAW), 512, 0}; pg8::gemm_phase<pg8::EpiOut<0>, pg8::StaticOrder, true, true>(C.lds, g, S, E); }) PH_END(id)
        ++id;
        PH_BEGIN(id) MP_REP(ph_mix_post(CL, A, l, false, mrows);) ph_mix_post(CL, A, l, true, mrows); PH_END(id)
        ++id;
        PH_BEGIN(id) GEMM_REP({ pg8::Gemm g{WSA(bf16, WS_MERGED), (const bf16*)(wl + WT_OUT), NLAT, DM, DM, DM, 0, 1}; pg8::RevOrder S; S.init(NLAT, DM, C.G, C.bid, WGM_OUT);
            pg8::EpiOut<0> E{WSA(bf16, WS_OX), DM, 0}; pg8::gemm_phase<pg8::EpiOut<0>, pg8::RevOrder, true, true>(C.lds, g, S, E); })
            if (!last) { pg8::Gemm g{WSA(bf16, WS_MERGED) + (size_t)NLAT * DM, (const bf16*)(wl + WT_OUT), NCTX, DM, 256, DM, 0, 1}; pg8::SplitOrder S; S.init(NCTX, DM, 8, 256, C.G, C.bid);
                pg8::EpiPart E{WSA(float, WS_PART), DM, (size_t)NCTX * DM}; pg8::gemm_phase<pg8::EpiPart, pg8::SplitOrder, true, true>(C.lds, g, S, E); } PH_END(id)
        ++id;
        PH_BEGIN(id)
            if (l == 0) ph_rownorm<true, false>(CL, A, true, PIN(I_GPOSTMIX) + l * DM, modl + 2 * DM, true, PIN(I_GPREMLP) + l * DM, modl + 3 * DM, modl + 4 * DM, mrows, 8);
            else ph_rownorm<false, false>(CL, A, true, PIN(I_GPOSTMIX) + l * DM, modl + 2 * DM, true, PIN(I_GPREMLP) + l * DM, modl + 3 * DM, modl + 4 * DM, mrows, 8);
        PH_END(id)
        ++id;
        PH_BEGIN(id) GEMMU_REP({ pg8::Gemm g{WSA(bf16, WS_HX), (const bf16*)(wl + WT_UP), mrows, MLPH, DM, DM, 0, 1}; pg8::RevOrder S; S.init(mrows, MLPH, C.G, C.bid, WGM_UP);
            pg8::EpiOut<1> E{WSA(bf16, WS_H), MLPH, 1}; pg8::gemm_phase<pg8::EpiOut<1>, pg8::RevOrder, true, true>(C.lds, g, S, E); }) PH_END(id)
        ++id;
        PH_BEGIN(id)
#if PROBE_GD0
            { pg8::Gemm g{WSA(bf16, WS_H), (const bf16*)(wl + WT_DOWN), NLAT, DM, MLPH, MLPH, 1, 1}; pg8::FakeOrder S; S.init(NLAT, DM, C.G, C.bid);
              pg8::EpiOut<0> E{WSA(bf16, WS_OX), DM, 0}; pg8::gemm_phase<pg8::EpiOut<0>, pg8::FakeOrder, true, true>(C.lds, g, S, E); } __syncthreads();
#endif
            GEMMD_REP({ pg8::Gemm g{WSA(bf16, WS_H), (const bf16*)(wl + WT_DOWN), NLAT, DM, MLPH, MLPH, 1, 1}; pg8::StaticOrder S; S.init(NLAT, DM, C.G, C.bid, WGM_DOWN);
            pg8::EpiOut<0> E{WSA(bf16, WS_OX), DM, 0}; pg8::gemm_phase<pg8::EpiOut<0>, pg8::StaticOrder, true, true>(C.lds, g, S, E); })
            if (!last) { pg8::Gemm g{WSA(bf16, WS_H) + (size_t)NLAT * MLPH, (const bf16*)(wl + WT_DOWN), NCTX, DM, 512, MLPH, 1, 1}; pg8::SplitOrder S; S.init(NCTX, DM, 16, 512, C.G, C.bid);
                pg8::EpiPart E{WSA(float, WS_PART), DM, (size_t)NCTX * DM}; pg8::gemm_phase<pg8::EpiPart, pg8::SplitOrder, true, true>(C.lds, g, S, E); } PH_END(id)
        ++id;
        PH_BEGIN(id)
            if (l + 1 < DEPTH) { const float* modn = modl + 3 * MODW;
                ph_rownorm<false, false>(CL, A, true, PIN(I_GPOSTMLP) + l * DM, modl + 5 * DM, true, PIN(I_GPREMIX) + (l + 1) * DM, modn + 0 * DM, modn + 1 * DM, MROWS, 16);
                MLP_REP(ph_filter_mlp(CL, A, l + 1);) }
            else ph_rownorm<false, true>(CL, A, true, PIN(I_GPOSTMLP) + l * DM, modl + 5 * DM, false, nullptr, nullptr, nullptr, NLAT, 0);
        PH_END(id)
        ++id;
    }
#undef PH_BEGIN
#undef PH_END
#if TPROBE
    if (C.bid == 0 && C.wave == 0) {
        const volatile unsigned long long* ts = TP_TS;
        const unsigned long long t0 = ts[0];
        float metric = 0.f, prevmax = 0.f;
#pragma unroll 1
        for (int p = 0; p <= NPHASES; ++p) {
            float mx = -1e30f, sm = 0.f;
            for (int k = 0; k < 4; ++k) { const float v = (float)(long long)(ts[p * 256 + C.lane + 64 * k] - t0); mx = fmaxf(mx, v); sm += v; }
            for (int o = 32; o; o >>= 1) { mx = fmaxf(mx, __shfl_xor(mx, o)); sm += __shfl_xor(sm, o); }
            if (p > 0 && (TP_SEL((p - 1)))) metric += TP_MODE ? (mx - sm * (1.f / 256.f)) : (mx - prevmax);
            prevmax = mx;
        }
        const unsigned long long spin = (unsigned long long)(metric * TP_SCALE), tb = __builtin_amdgcn_s_memrealtime();
        while (__builtin_amdgcn_s_memrealtime() - tb < spin) __builtin_amdgcn_s_sleep(8);
    }
#endif
}

extern "C" void kernel_launch(void* const* d_in, const int* in_sizes, int n_in, void* d_out, int out_size, void* d_ws, size_t ws_size, hipStream_t stream) {
    static int grid = 0;
    if (grid == 0) {
        if (n_in != NIN || in_sizes[0] != NLAT * DM || out_size != NLAT * DM || ws_size < WS_END) {
            fprintf(stderr, "kernel_launch: shape mismatch: n_in %d in0 %d out %d ws %zu (need %zu); nothing launched\n", n_in, n_in > 0 ? in_sizes[0] : -1, out_size, ws_size, (size_t)WS_END); grid = -1; return; }
        int dev = 0, cus = 0, per_cu = 0;
        if (hipGetDevice(&dev) != hipSuccess || hipDeviceGetAttribute(&cus, hipDeviceAttributeMultiprocessorCount, dev) != hipSuccess) { fprintf(stderr, "kernel_launch: device query failed\n"); grid = -1; return; }
        if (hipFuncSetAttribute((const void*)trunk_fwd, hipFuncAttributeMaxDynamicSharedMemorySize, LDS_BYTES) != hipSuccess) { fprintf(stderr, "kernel_launch: hipFuncSetAttribute failed\n"); grid = -1; return; }
        if (hipOccupancyMaxActiveBlocksPerMultiprocessor(&per_cu, (const void*)trunk_fwd, 512, LDS_BYTES) != hipSuccess || per_cu < 1)
            fprintf(stderr, "kernel_launch: note: occupancy query reports %d workgroups per CU\n", per_cu);
        (void)hipGetLastError();
        grid = (cus < 256 ? cus : 256) & ~7;
    }
    if (grid < 0) return;
    if (hipMemsetAsync((char*)d_ws + WS_CTL, 0, CTL_ZERO_BYTES, stream) != hipSuccess) { fprintf(stderr, "kernel_launch: memset failed\n"); return; }
    Args a{};
    for (int i = 0; i < NIN; ++i) a.in[i] = (const float*)d_in[i];
    a.out = (float*)d_out; a.ws = (unsigned char*)d_ws;
#if MK_PER_PHASE
    for (int ph = 0; ph < NPHASES; ++ph) { a.ph_lo = ph; a.ph_hi = ph + 1;
        hipLaunchKernelGGL(trunk_fwd, dim3(grid), dim3(512), LDS_BYTES, stream, a); }
#else
    a.ph_lo = 0; a.ph_hi = NPHASES;
    hipLaunchKernelGGL(trunk_fwd, dim3(grid), dim3(512), LDS_BYTES, stream, a);
#endif
    const hipError_t le = hipPeekAtLastError();
    if (le != hipSuccess) fprintf(stderr, "kernel_launch: launch failed: %s\n", hipGetErrorName(le));
}
```

```cpp
#include <hip/hip_runtime.h>
#include <cstdio>
#include <cstdint>
#include <type_traits>
#ifndef MK_PER_PHASE
#define MK_PER_PHASE 0
#endif
#ifndef PG8_AUX_A
#define PG8_AUX_A 0
#endif
namespace pg8 {
#define PG8_LAS __attribute__((address_space(3)))
typedef unsigned short bf16_t;
typedef short bf16x8 __attribute__((ext_vector_type(8)));
typedef float f32x4 __attribute__((ext_vector_type(4)));
typedef unsigned u32x4 __attribute__((ext_vector_type(4)));
constexpr int BM = 256, BK = 64, HALF = 128, HTB = HALF * BK * 2  , STAGE_BYTES = 8 * HTB, NXCD = 8, WGM = 8;

__host__ __device__ __forceinline__ int lds_byte(int r, int c) { const int st = (r >> 4) * 2 + (c >> 5), rr = r & 15, cc = c & 31, ob = rr * 64 + cc * 2; return st * 1024 + (ob ^ (((ob >> 9) & 1) << 5)); }
__host__ __device__ __forceinline__ void stage_rc(int b, int& R, int& C) { const int st = b / 1024, sb = b % 1024, swz = sb ^ (((sb >> 9) & 1) << 5); R = (st >> 1) * 16 + swz / 64; C = (st & 1) * 32 + (swz % 64) / 2; }
__host__ __device__ __forceinline__ int perm32(int rho) { const int n = rho >> 4, i = rho & 15; return 8 * (i >> 2) + 4 * n + (i & 3); }

__device__ __forceinline__ int pg8_tid() { int t = threadIdx.x; asm volatile("" : "+v"(t)); return t; }
struct Unit { int pm, pn, ko, ks; };
struct Gemm { const bf16_t* A; const bf16_t* Bt; int M, N, K, ld, tiledA, tiledB; };

struct StaticOrder {
    int nM, nN, nwg, G, c, wgm;
    __host__ __device__ void init(int M, int N, int G_, int c_, int wgm_ = WGM) { nM = M / BM; nN = N / BM; nwg = nM * nN; G = G_; c = c_; wgm = wgm_; }
    __host__ __device__ bool next(int i, Unit& u) const {
        const long L = (long)i * G + c; if (L >= nwg) return false;
        int wgid = (int)L; { const int q = nwg / NXCD, r = nwg % NXCD, xcd = wgid % NXCD, off = wgid / NXCD; wgid = (xcd < r ? xcd * (q + 1) : r * (q + 1) + (xcd - r) * q) + off; }
        const int nig = wgm * nN, gid = wgid / nig, fm = gid * wgm, gsz = (nM - fm) < wgm ? (nM - fm) : wgm;
        u.pm = fm + ((wgid % nig) % gsz); u.pn = (wgid % nig) / gsz; u.ko = 0; u.ks = -1; return true;
    }
    __device__ __forceinline__ void a_ready(const Unit&) const {}
    __device__ __forceinline__ void done(const Unit&) const {}
};
struct FakeOrder : StaticOrder { __host__ __device__ bool next(int i, Unit& u) const { const bool ok = StaticOrder::next(i, u); u.pm = 0; u.pn = 0; return ok; } };
struct RevOrder : StaticOrder { __host__ __device__ bool next(int i, Unit& u) const { const bool ok = StaticOrder::next(i, u); u.pm = nM - 1 - u.pm; return ok; } };
struct SplitOrder {
    int nM, ntile, nsub, ksub, G, c;
    __host__ __device__ void init(int M, int N, int nslices, int ksub_, int G_, int c_) { nM = M / BM; ntile = nM * (N / BM); nsub = ntile * nslices; ksub = ksub_; G = G_; c = c_; }
    __host__ __device__ bool next(int i, Unit& u) const { const long L = (long)i * G + c; if (L >= nsub) return false; const int s = (int)L, tile = s % ntile, ks = s / ntile;
        u.pm = tile % nM; u.pn = tile / nM; u.ko = ks * ksub; u.ks = ks; return true; }
    __device__ __forceinline__ void a_ready(const Unit&) const {}
    __device__ __forceinline__ void done(const Unit&) const {}
};
__device__ __forceinline__ unsigned cvt_pk_bf16(float lo, float hi) { unsigned r; asm volatile("v_cvt_pk_bf16_f32 %0, %1, %2" : "=v"(r) : "v"(lo), "v"(hi)); return r; }
template <int ACT> struct EpiOut {
    static constexpr bool PERM = true, AFTER_DRAIN = false;
    bf16_t* O; int ldc; int tiled;
    __device__ __forceinline__ void operator()(const f32x4 (&acc)[2][2][4][2], const Unit& u, int wr, int wc, int fr, int fq) const {
        const int row0 = u.pm * BM + wr * 64 + fr; const int col0 = u.pn * BM + wc * 32 + 8 * fq;
#pragma unroll
        for (int ai = 0; ai < 2; ++ai)
#pragma unroll
            for (int m = 0; m < 4; ++m) { const int row = row0 + ai * HALF + m * 16; bf16_t* rowp = O + (size_t)row * ldc + col0;
#pragma unroll
                for (int bj = 0; bj < 2; ++bj) { f32x4 v0 = acc[ai][bj][m][0], v1 = acc[ai][bj][m][1];
                    if (ACT == 1) {
#pragma unroll
                        for (int j = 0; j < 4; ++j) { const float a = v0[j] > 0.f ? v0[j] : 0.f, b = v1[j] > 0.f ? v1[j] : 0.f; v0[j] = a * a; v1[j] = b * b; } }
                    u32x4 w; w.x = cvt_pk_bf16(v0[0], v0[1]); w.y = cvt_pk_bf16(v0[2], v0[3]); w.z = cvt_pk_bf16(v1[0], v1[1]); w.w = cvt_pk_bf16(v1[2], v1[3]);
                    if (tiled) { const int col = col0 + bj * HALF; *(u32x4*)(O + ((size_t)(row >> 8) * (ldc >> 6) + (col >> 6)) * 16384 + (size_t)((row & 255) * 64 + (col & 63))) = w; }
                    else *(u32x4*)(rowp + bj * HALF) = w; } }
    }
};
struct EpiPart {
    static constexpr bool PERM = false, AFTER_DRAIN = false;
    float* P; int ldc; size_t slice_stride;
    __device__ __forceinline__ void operator()(const f32x4 (&acc)[2][2][4][2], const Unit& u, int wr, int wc, int fr, int fq) const {
        const int row0 = u.pm * BM + wr * 64 + fr, col0 = u.pn * BM + wc * 32 + 4 * fq; float* base = P + (size_t)u.ks * slice_stride;
#pragma unroll
        for (int ai = 0; ai < 2; ++ai)
#pragma unroll
            for (int m = 0; m < 4; ++m) { float* rowp = base + (size_t)(row0 + ai * HALF + m * 16) * ldc + col0;
#pragma unroll
                for (int bj = 0; bj < 2; ++bj)
#pragma unroll
                    for (int n = 0; n < 2; ++n) *(f32x4*)(rowp + bj * HALF + n * 16) = acc[ai][bj][m][n]; }
    }
};
template <class Epi, class Sched, bool ALIGN_EPI = false, bool SP2 = false>
__device__ __forceinline__ void gemm_phase(PG8_LAS unsigned char* lds, const Gemm g, const Sched& S, const Epi& E) {
    const int tid = pg8_tid(), wid = __builtin_amdgcn_readfirstlane(tid >> 6), lane = tid & 63, wr = wid >> 2, wc = wid & 3, fr = lane & 15, fq = lane >> 4;
    const int K = g.ld, nt = g.K / BK;
    unsigned voffA[2], voffB[2];
#pragma unroll
    for (int i = 0; i < 2; ++i) { int R, C; stage_rc(tid * 16 + i * 8192, R, C); const int Rb = Epi::PERM ? ((R & ~31) + perm32(R & 31)) : R;
        voffA[i] = g.tiledA ? (unsigned)(R * BK + C) * 2u : (unsigned)(R * K + C) * 2u; voffB[i] = g.tiledB ? (unsigned)(Rb * BK + C) * 2u : (unsigned)(Rb * K + C) * 2u; }
    const size_t kstepA = g.tiledA ? (size_t)(BM * BK * 2) : (size_t)(BK * 2), kstepB = g.tiledB ? (size_t)(BM * BK * 2) : (size_t)(BK * 2);
    const size_t hstep = (size_t)HALF * K * 2, hstepA = g.tiledA ? (size_t)(HALF * BK * 2) : hstep, hstepB = g.tiledB ? (size_t)(HALF * BK * 2) : hstep;
    const size_t koA = g.tiledA ? (size_t)(BM * 2) : 2, koB = g.tiledB ? (size_t)(BM * 2) : 2;
    const size_t tstep = 2 * hstep;
    const unsigned ldsw = (unsigned)wid * 1024u;
    const int aoff = lds_byte(wr * 64 + fr, fq * 8), boff = lds_byte(wc * 32 + fr, fq * 8);
#define PG8_SA(b, h) (((b) * 2 + (h)) * HTB)
#define PG8_SB(b, h) ((4 + (b) * 2 + (h)) * HTB)
#define PG8_STAGE(bufoff, gbase, voff) do { _Pragma("unroll") for (int _i = 0; _i < 2; ++_i) \
        __builtin_amdgcn_global_load_lds((const unsigned*)((const char*)(gbase) + (voff)[_i]), (PG8_LAS unsigned*)(lds + (bufoff) + ldsw + _i * 8192), 16, 0, 0); } while (0)
#define PG8_LDA(dst, b, h) do { _Pragma("unroll") for (int m = 0; m < 4; ++m) _Pragma("unroll") for (int k = 0; k < 2; ++k) dst[m][k] = *(const PG8_LAS bf16x8*)(lds + PG8_SA(b, h) + aoff + m * 2048 + k * 1024); } while (0)
#define PG8_LDB(dst, b, h) do { _Pragma("unroll") for (int n = 0; n < 2; ++n) _Pragma("unroll") for (int k = 0; k < 2; ++k) dst[n][k] = *(const PG8_LAS bf16x8*)(lds + PG8_SB(b, h) + boff + n * 2048 + k * 1024); } while (0)
#define PG8_MMA(ai, bj, At, Bt) do { __builtin_amdgcn_s_setprio(1); _Pragma("unroll") for (int m = 0; m < 4; ++m) _Pragma("unroll") for (int n = 0; n < 2; ++n) _Pragma("unroll") for (int k = 0; k < 2; ++k) \
        acc[ai][bj][m][n] = __builtin_amdgcn_mfma_f32_16x16x32_bf16(Bt[n][k], At[m][k], acc[ai][bj][m][n], 0, 0, 0); __builtin_amdgcn_s_setprio(0); } while (0)
#define PG8_WAIT_V(n) asm volatile("s_waitcnt vmcnt(" #n ")" ::: "memory")
#define PG8_WAIT_L(n) asm volatile("s_waitcnt lgkmcnt(" #n ")" ::: "memory")
#define PG8_BAR __builtin_amdgcn_s_barrier()
#define PG8_SCHED __builtin_amdgcn_sched_barrier(0)
    Unit cur, nxt; int ui = 0;
    if (!S.next(0, cur)) return;
    f32x4 acc[2][2][4][2];
#pragma unroll
    for (int a = 0; a < 2; ++a)
#pragma unroll
        for (int b = 0; b < 2; ++b)
#pragma unroll
            for (int m = 0; m < 4; ++m)
#pragma unroll
                for (int n = 0; n < 2; ++n) acc[a][b][m][n] = (f32x4){0.f, 0.f, 0.f, 0.f};
    bf16x8 At[4][2], B0[2][2], B1[2][2];
    const char* cA = (const char*)g.A + (size_t)cur.pm * tstep + (size_t)cur.ko * koA; const char* cB = (const char*)g.Bt + (size_t)cur.pn * tstep + (size_t)cur.ko * koB;
    S.a_ready(cur);
    if constexpr (SP2) {
        PG8_STAGE(PG8_SB(0, 0), cB, voffB); PG8_STAGE(PG8_SB(0, 1), cB + hstepB, voffB); PG8_STAGE(PG8_SA(0, 0), cA, voffA); PG8_STAGE(PG8_SA(0, 1), cA + hstepA, voffA);
        if (wr == 1) PG8_BAR;
        PG8_WAIT_V(2); PG8_BAR;
        PG8_STAGE(PG8_SB(1, 0), cB + kstepB, voffB); PG8_STAGE(PG8_SA(1, 0), cA + kstepA, voffA); PG8_STAGE(PG8_SB(1, 1), cB + hstepB + kstepB, voffB);
        PG8_WAIT_V(6); PG8_BAR;
    } else {
        PG8_STAGE(PG8_SB(0, 0), cB, voffB); PG8_STAGE(PG8_SA(0, 0), cA, voffA); PG8_STAGE(PG8_SB(0, 1), cB + hstepB, voffB); PG8_STAGE(PG8_SA(0, 1), cA + hstepA, voffA);
        if (wr == 1) PG8_BAR;
        PG8_WAIT_V(4); PG8_BAR;
        PG8_STAGE(PG8_SB(1, 0), cB + kstepB, voffB); PG8_STAGE(PG8_SA(1, 0), cA + kstepA, voffA); PG8_STAGE(PG8_SB(1, 1), cB + hstepB + kstepB, voffB);
        PG8_WAIT_V(6); PG8_BAR;
    }
    for (;;) {
        const bool has_next = S.next(ui + 1, nxt);
        const char* nA = has_next ? (const char*)g.A + (size_t)nxt.pm * tstep + (size_t)nxt.ko * koA : cA; const char* nB = has_next ? (const char*)g.Bt + (size_t)nxt.pn * tstep + (size_t)nxt.ko * koB : cB;
        for (int t = 0; t < nt; t += 2) {
            const bool last = (t == nt - 2);
            const char* a1 = cA + (size_t)(t + 1) * kstepA;
            const char* a2 = last ? nA : cA + (size_t)(t + 2) * kstepA; const char* b2 = last ? nB : cB + (size_t)(t + 2) * kstepB;
            const char* a3 = a2 + kstepA; const char* b3 = b2 + kstepB;
            if (last && has_next) S.a_ready(nxt);
            if constexpr (SP2) {
            PG8_LDB(B0, 0, 0); PG8_LDB(B1, 0, 1); PG8_SCHED; PG8_LDA(At, 0, 0); PG8_STAGE(PG8_SA(1, 1), a1 + hstepA, voffA);
            PG8_WAIT_V(8); PG8_WAIT_L(0); PG8_BAR; PG8_MMA(0, 0, At, B0); PG8_MMA(0, 1, At, B1); PG8_BAR; PG8_SCHED;
            PG8_LDA(At, 0, 1); PG8_STAGE(PG8_SB(0, 0), b2, voffB); PG8_STAGE(PG8_SB(0, 1), b2 + hstepB, voffB); PG8_STAGE(PG8_SA(0, 0), a2, voffA);
            PG8_WAIT_V(8); PG8_WAIT_L(0); PG8_BAR; PG8_MMA(1, 0, At, B0); PG8_MMA(1, 1, At, B1); PG8_BAR; PG8_SCHED;
            PG8_LDB(B0, 1, 0); PG8_LDB(B1, 1, 1); PG8_SCHED; PG8_LDA(At, 1, 0); PG8_STAGE(PG8_SA(0, 1), a2 + hstepA, voffA);
            PG8_WAIT_V(8); PG8_WAIT_L(0); PG8_BAR; PG8_MMA(0, 0, At, B0); PG8_MMA(0, 1, At, B1); PG8_BAR; PG8_SCHED;
            PG8_LDA(At, 1, 1); PG8_STAGE(PG8_SB(1, 0), b3, voffB); PG8_STAGE(PG8_SB(1, 1), b3 + hstepB, voffB); PG8_STAGE(PG8_SA(1, 0), a3, voffA);
            PG8_WAIT_V(8); PG8_WAIT_L(0); PG8_BAR; PG8_MMA(1, 0, At, B0); PG8_MMA(1, 1, At, B1); PG8_BAR; PG8_SCHED;
            } else {
            PG8_LDB(B0, 0, 0); PG8_SCHED; PG8_LDA(At, 0, 0); PG8_STAGE(PG8_SA(1, 1), a1 + hstepA, voffA);
            PG8_WAIT_L(8); PG8_BAR; PG8_WAIT_L(0); PG8_MMA(0, 0, At, B0); PG8_BAR; PG8_SCHED;
            PG8_LDB(B1, 0, 1); PG8_STAGE(PG8_SB(0, 0), b2, voffB);
            PG8_BAR; PG8_WAIT_L(0); PG8_MMA(0, 1, At, B1); PG8_BAR;
            PG8_LDA(At, 0, 1); PG8_STAGE(PG8_SA(0, 0), a2, voffA);
            PG8_BAR; PG8_WAIT_L(0); PG8_MMA(1, 0, At, B0); PG8_BAR; PG8_SCHED;
            PG8_STAGE(PG8_SB(0, 1), b2 + hstepB, voffB);
            PG8_WAIT_V(6); PG8_BAR; PG8_MMA(1, 1, At, B1); PG8_BAR;
            PG8_LDB(B0, 1, 0); PG8_SCHED; PG8_LDA(At, 1, 0); PG8_STAGE(PG8_SA(0, 1), a2 + hstepA, voffA);
            PG8_WAIT_L(8); PG8_BAR; PG8_WAIT_L(0); PG8_MMA(0, 0, At, B0); PG8_BAR; PG8_SCHED;
            PG8_LDB(B1, 1, 1); PG8_STAGE(PG8_SB(1, 0), b3, voffB);
            PG8_BAR; PG8_WAIT_L(0); PG8_MMA(0, 1, At, B1); PG8_BAR;
            PG8_LDA(At, 1, 1); PG8_STAGE(PG8_SA(1, 0), a3, voffA);
            PG8_BAR; PG8_WAIT_L(0); PG8_MMA(1, 0, At, B0); PG8_BAR; PG8_SCHED;
            PG8_STAGE(PG8_SB(1, 1), b3 + hstepB, voffB);
            PG8_WAIT_V(6); PG8_BAR; PG8_MMA(1, 1, At, B1); PG8_BAR;
            }
        }
        if constexpr (ALIGN_EPI) { if (wr == 0) PG8_BAR; }
        if constexpr (!Epi::AFTER_DRAIN) { E(acc, cur, wr, wc, fr, fq); S.done(cur); }
        if (!has_next) break;
#pragma unroll
        for (int a = 0; a < 2; ++a)
#pragma unroll
            for (int b = 0; b < 2; ++b)
#pragma unroll
                for (int m = 0; m < 4; ++m)
#pragma unroll
                    for (int n = 0; n < 2; ++n) acc[a][b][m][n] = (f32x4){0.f, 0.f, 0.f, 0.f};
        cur = nxt; cA = nA; cB = nB; ++ui;
        if constexpr (ALIGN_EPI) { if (wr == 1) PG8_BAR; }
    }
    PG8_WAIT_V(0);
    if constexpr (!ALIGN_EPI) { if (wr == 0) PG8_BAR; }
    PG8_BAR;
    if constexpr (Epi::AFTER_DRAIN) { E.fused(acc, cur, wr, wc, fr, fq, lds, wid, lane); S.done(cur); }
#undef PG8_SA
#undef PG8_SB
#undef PG8_STAGE
#undef PG8_LDA
#undef PG8_LDB
#undef PG8_MMA
#undef PG8_WAIT_V
#undef PG8_WAIT_L
#undef PG8_BAR
#undef PG8_SCHED
}
}
#define LAS __attribute__((address_space(3)))
#define XB_TMO      128
#define XB_XCNT(j)  (256  + 64 * (j))
#define XB_XSUB(j)  (1280 + 64 * (j))
#define XB_XGEN(j)  (2304 + 64 * (j))
#define XB_TOP      3328
#define XB_TOPGEN   3392
#define XCD_BAR_WORDS 3456
#define XB_SPIN_CAP (1u << 18)

__device__ __forceinline__ unsigned xb_ld(unsigned* p)              { return __hip_atomic_load(p, __ATOMIC_RELAXED, __HIP_MEMORY_SCOPE_AGENT); }
__device__ __forceinline__ unsigned xb_add(unsigned* p, unsigned v) { return __hip_atomic_fetch_add(p, v, __ATOMIC_RELAXED, __HIP_MEMORY_SCOPE_AGENT); }
__device__ __forceinline__ unsigned xb_xcc_id() { return (unsigned)__builtin_amdgcn_s_getreg((3 << 11) | 20) & 0xFu; }
#define XB_SPIN(cond, bar) do { unsigned _sp = 0; while (cond) { __builtin_amdgcn_s_sleep(1); \
    if ((++_sp & 255u) == 0u) { if (xb_ld(&(bar)[XB_TMO])) break; if (_sp > XB_SPIN_CAP) { atomicAdd(&(bar)[XB_TMO], 1u); break; } } } } while (0)

struct XcdBarrier {
    unsigned* bar; unsigned x;
    volatile LAS unsigned* st;
};

__device__ __forceinline__ XcdBarrier xcd_barrier_post(unsigned* bar, volatile LAS unsigned* st) {
    XcdBarrier b; b.bar = bar; b.x = xb_xcc_id(); b.st = st;
    if (threadIdx.x == 0) (void)xb_add(&bar[XB_XCNT(b.x)], 1u);
    return b;
}
__device__ __forceinline__ void xcd_barrier_complete(unsigned* bar, unsigned x, unsigned& nloc, unsigned& nx) {
    const unsigned G = gridDim.x * gridDim.y * gridDim.z;
    unsigned sum, cnt, mine, sp = 0u;
    for (;;) {
        sum = 0u; cnt = 0u; mine = 0u;
#pragma unroll
        for (unsigned j = 0; j < 16; ++j) { const unsigned c = xb_ld(&bar[XB_XCNT(j)]); sum += c; cnt += (c > 0u) ? 1u : 0u; mine = (j == x) ? c : mine; }
        if (sum == G) break;
        __builtin_amdgcn_s_sleep(1);
        if ((++sp & 255u) == 0u) { if (xb_ld(&bar[XB_TMO])) break; if (sp > XB_SPIN_CAP) { atomicAdd(&bar[XB_TMO], 1u); break; } }
    }
    nloc = mine > 0u ? mine : 1u; nx = cnt > 0u ? cnt : 1u;
}

__device__ __forceinline__ void xcd_barrier(const XcdBarrier& b) {
    asm volatile("s_waitcnt vmcnt(0)" ::: "memory");
    __syncthreads();
    if (threadIdx.x == 0) {
        unsigned* bar = b.bar;
        __builtin_amdgcn_s_waitcnt(0);
        unsigned nloc = b.st[0], nx = b.st[1];
        if (nloc == 0u) { xcd_barrier_complete(bar, b.x, nloc, nx); b.st[0] = nloc; b.st[1] = nx; }
        const unsigned old = xb_add(&bar[XB_XSUB(b.x)], 1u);
        const unsigned gen = old / nloc;
        if (old + 1u == (gen + 1u) * nloc) {
            __builtin_amdgcn_fence(__ATOMIC_RELEASE, "agent");
            asm volatile("s_waitcnt vmcnt(0)" ::: "memory");
            const unsigned og = xb_add(&bar[XB_TOP], 1u);
            const unsigned tg = og / nx;
            if (og + 1u == (tg + 1u) * nx) xb_add(&bar[XB_TOPGEN], 1u);
            else XB_SPIN(xb_ld(&bar[XB_TOPGEN]) == tg, bar);
            __builtin_amdgcn_fence(__ATOMIC_ACQUIRE, "agent");
            xb_add(&bar[XB_XGEN(b.x)], 1u);
            asm volatile("s_waitcnt vmcnt(0)" ::: "memory");
        } else {
            XB_SPIN(xb_ld(&bar[XB_XGEN(b.x)]) == gen, bar);
            __builtin_amdgcn_fence(__ATOMIC_ACQUIRE, "agent");
            asm volatile("s_waitcnt vmcnt(0)" ::: "memory");
        }
    }
    __syncthreads();
}
constexpr int DM = 2048, NB = 2, SEQ = 16384, DEPTH = 4, CTXL = 256;
constexpr int NLAT = NB * SEQ, NCTX = NB * CTXL, MROWS = NLAT + NCTX;
constexpr int INW = 3584, Q_END = 1024, K_END = 1280, V_END = 1536, HY_END = 3072;
constexpr int HYW = 512, PLW = 512, MLPH = 8192, MODW = 6 * DM;
constexpr float EPS = 1e-6f;
constexpr int NIN = 28;
enum { I_X = 0, I_C, I_CTX, I_CCTX, I_WMOD, I_BMOD, I_GPREMIX, I_GPOSTMIX, I_GPREMLP, I_GPOSTMLP, I_WIN, I_WOUT, I_GBRANCH, I_SINK, I_HCW, I_HCB,
       I_HW1, I_HB1, I_HF1, I_HW2, I_HB2, I_HF2, I_HW3, I_HBIAS, I_POOLW, I_POOLS, I_WUP, I_WDOWN };

constexpr size_t MiB = 1u << 20;
constexpr size_t WS_CTL = 0, CTL_ZERO_BYTES = 1 * MiB;
constexpr size_t WS_MOD = 1 * MiB;
constexpr size_t WS_ROPE = 2 * MiB;
constexpr size_t WS_TW = 2 * MiB + 128 * 1024;
constexpr size_t WS_FPART = 3 * MiB;
constexpr size_t WS_XC = 6 * MiB;
constexpr size_t WS_MODP = 10 * MiB;
constexpr size_t WS_YA = 28 * MiB;
constexpr size_t WS_WT = 60 * MiB;
constexpr size_t WT_IN = 0, WT_OUT = 14 * MiB, WT_UP = 22 * MiB, WT_DOWN = 54 * MiB, WT_POOL = 86 * MiB, WT_LAYER = 86 * MiB + MiB / 2;
constexpr size_t WS_HX = 406 * MiB;
constexpr size_t WS_OX = 536 * MiB;
constexpr size_t WS_U = 666 * MiB;
constexpr size_t WS_H = WS_U;
constexpr size_t WS_PX = WS_U;
constexpr size_t WS_MERGED = WS_U + 228 * MiB;
constexpr size_t WS_POOLED = WS_U + 358 * MiB;
constexpr size_t WS_PORAW = WS_U + 391 * MiB;
constexpr size_t WS_VT = WS_U + 424 * MiB;
constexpr size_t WS_YT = WS_U + 457 * MiB;
constexpr size_t WS_HF = 1190 * MiB;
constexpr size_t WS_HFC = WS_HF + 64 * MiB;
constexpr size_t WS_SPEC = 1255 * MiB;
constexpr size_t WS_PART = WS_SPEC;
constexpr size_t WS_XB = 1384 * MiB;
constexpr size_t WS_END = 1514 * MiB;
static_assert(WS_WT + DEPTH * WT_LAYER <= WS_HX && WS_YT + (size_t)512 * MROWS * 4 <= WS_HF && WS_H + (size_t)MROWS * MLPH * 2 <= WS_HF, "d_ws map");

constexpr int LDS_RED = 139264;
constexpr int LDS_MISC = 140288;
constexpr int LDS_BYTES = 147456;

typedef unsigned short bf16;
typedef float f32x4 __attribute__((ext_vector_type(4)));
typedef float cf32 __attribute__((ext_vector_type(2)));
typedef short bf16x8 __attribute__((ext_vector_type(8)));
typedef short s16x4 __attribute__((ext_vector_type(4)));
typedef float f32x16 __attribute__((ext_vector_type(16)));
typedef unsigned u32x4 __attribute__((ext_vector_type(4)));
typedef unsigned u32x2 __attribute__((ext_vector_type(2)));
#define make_cf32(a, b) ((cf32){(a), (b)})

__device__ __forceinline__ unsigned f2bf(float f) { unsigned u = __builtin_bit_cast(unsigned, f); return (u + 0x7fffu + ((u >> 16) & 1u)) >> 16; }
__device__ __forceinline__ unsigned pk2(float lo, float hi) { return f2bf(lo) | (f2bf(hi) << 16); }
__device__ __forceinline__ float bf2f(unsigned short b) { return __builtin_bit_cast(float, (unsigned)b << 16); }
__device__ __forceinline__ float bflo(unsigned w) { return __builtin_bit_cast(float, w << 16); }
__device__ __forceinline__ float bfhi(unsigned w) { return __builtin_bit_cast(float, w & 0xffff0000u); }
__device__ __forceinline__ float wave_sum(float v) {
#pragma unroll
    for (int o = 1; o < 64; o <<= 1) v += __shfl_xor(v, o);
    return v;
}
struct Ctx {
    const float* in[NIN]; float* out; unsigned char* ws;
    LAS unsigned char* lds; char* ldsg;
    int tid, lane, wave, bid, G;
};
#define WSP(T, off) ((T*)(C.ws + (off)))

#define FFT_DEV __device__ __forceinline__
#define FFT_LDS LAS
#define FFT_SINCOSPI(x, s, c) do { *(s) = sinpif(x); *(c) = cospif(x); } while (0)
#define FFT_SYNC() __syncthreads()
__device__ __forceinline__ int fft_launder(int t) { asm volatile("" : "+v"(t)); return t; }
#define FFT_LAUNDER(t) fft_launder(t)
constexpr int FFT_N = 16384;
FFT_DEV int fpad(int i) { return i + (i >> 4); }
constexpr int FFT_SLOTS = FFT_N + (FFT_N >> 4);
FFT_DEV cf32 cadd(cf32 a, cf32 b) { return a + b; }
FFT_DEV cf32 csub(cf32 a, cf32 b) { return a - b; }
FFT_DEV cf32 cmul(cf32 a, cf32 b) { return a.xx * b + make_cf32(-a.y, a.y) * b.yx; }
FFT_DEV cf32 cmulc(cf32 a, cf32 b) { return b.xx * a + make_cf32(b.y, -b.y) * a.yx; }
template <bool INV> FFT_DEV void dft4(cf32& a, cf32& b, cf32& c, cf32& d) {
    const cf32 s0 = cadd(a, c), s1 = csub(a, c), s2 = cadd(b, d), s3 = csub(b, d);
    const cf32 t = INV ? make_cf32(-s3.y, s3.x) : make_cf32(s3.y, -s3.x);
    a = cadd(s0, s2); c = csub(s0, s2); b = cadd(s1, t); d = csub(s1, t);
}
template <bool INV> FFT_DEV void dft16(cf32 (&v)[16]) {
#pragma unroll
    for (int b = 0; b < 4; ++b) dft4<INV>(v[b], v[4 + b], v[8 + b], v[12 + b]);
    const float C1 = 0.92387953251128674f, S1 = 0.38268343236508977f, R2 = 0.70710678118654752f;
    const cf32 w1 = make_cf32(C1, INV ? S1 : -S1), w2 = make_cf32(R2, INV ? R2 : -R2), w3 = make_cf32(S1, INV ? C1 : -C1);
    const cf32 w6 = make_cf32(-R2, INV ? R2 : -R2), w9 = make_cf32(-C1, INV ? -S1 : S1);
    const cf32 w4 = make_cf32(0.f, INV ? 1.f : -1.f);
    v[4 * 1 + 1] = cmul(v[4 * 1 + 1], w1); v[4 * 1 + 2] = cmul(v[4 * 1 + 2], w2); v[4 * 1 + 3] = cmul(v[4 * 1 + 3], w3);
    v[4 * 2 + 1] = cmul(v[4 * 2 + 1], w2); v[4 * 2 + 2] = cmul(v[4 * 2 + 2], w4); v[4 * 2 + 3] = cmul(v[4 * 2 + 3], w6);
    v[4 * 3 + 1] = cmul(v[4 * 3 + 1], w3); v[4 * 3 + 2] = cmul(v[4 * 3 + 2], w6); v[4 * 3 + 3] = cmul(v[4 * 3 + 3], w9);
#pragma unroll
    for (int q1 = 0; q1 < 4; ++q1) dft4<INV>(v[4 * q1], v[4 * q1 + 1], v[4 * q1 + 2], v[4 * q1 + 3]);
}
constexpr int FFT_TW0 = 0, FFT_TW1 = 15 * 1024, FFT_TW2 = 15 * 1024 + 15 * 64, FFT_TWN = 15 * 1024 + 15 * 64 + 15 * 4;
template <int L> struct fft_twbase { static constexpr int v = L == 16384 ? FFT_TW0 : (L == 1024 ? FFT_TW1 : FFT_TW2); };
template <int L, bool INV> FFT_DEV void fft_pass16(FFT_LDS cf32* buf, int tid, const cf32* tw) {
    constexpr int S = L / 16;
#pragma unroll 1
    for (int k = 0; k < 2; ++k) {
        const int bf = tid + 512 * k, g = bf / S, j = bf % S, base = g * L + j;
        cf32 v[16], w[16];
        const cf32* twj = tw + fft_twbase<L>::v + j;
#pragma unroll
        for (int q = 1; q < 16; ++q) w[q] = twj[(q - 1) * S];
        if (!INV) {
#pragma unroll
            for (int m = 0; m < 16; ++m) v[m] = buf[fpad(base + m * S)];
            dft16<false>(v);
#pragma unroll
            for (int q = 1; q < 16; ++q) { const int p = 4 * (q & 3) + (q >> 2); v[p] = cmul(v[p], w[q]); }
#pragma unroll
            for (int q = 0; q < 16; ++q) buf[fpad(base + q * S)] = v[4 * (q & 3) + (q >> 2)];
        } else {
#pragma unroll
            for (int q = 0; q < 16; ++q) v[q] = buf[fpad(base + q * S)];
#pragma unroll
            for (int q = 1; q < 16; ++q) v[q] = cmulc(v[q], w[q]);
            dft16<true>(v);
#pragma unroll
            for (int m = 0; m < 16; ++m) buf[fpad(base + m * S)] = v[4 * (m & 3) + (m >> 2)];
        }
    }
}
template <bool INV> FFT_DEV void fft_pass4(FFT_LDS cf32* buf, int tid) {
#pragma unroll 1
    for (int k = 0; k < 8; ++k) {
        const int b0 = fpad(4 * (tid + 512 * k));
        cf32 a = buf[b0], b = buf[b0 + 1], c = buf[b0 + 2], d = buf[b0 + 3];
        dft4<INV>(a, b, c, d);
        buf[b0] = a; buf[b0 + 1] = b; buf[b0 + 2] = c; buf[b0 + 3] = d;
    }
}
#ifndef FFT_LAUNDER
#define FFT_LAUNDER(t) (t)
#endif
#define FFT_FORWARD(buf, tid, tw) do { fft_pass16<16384, false>(buf, FFT_LAUNDER(tid), tw); FFT_SYNC(); fft_pass16<1024, false>(buf, FFT_LAUNDER(tid), tw); FFT_SYNC(); \
    fft_pass16<64, false>(buf, FFT_LAUNDER(tid), tw); FFT_SYNC(); fft_pass4<false>(buf, FFT_LAUNDER(tid)); FFT_SYNC(); } while (0)
#define FFT_INVERSE(buf, tid, tw) do { fft_pass4<true>(buf, FFT_LAUNDER(tid)); FFT_SYNC(); fft_pass16<64, true>(buf, FFT_LAUNDER(tid), tw); FFT_SYNC(); \
    fft_pass16<1024, true>(buf, FFT_LAUNDER(tid), tw); FFT_SYNC(); fft_pass16<16384, true>(buf, FFT_LAUNDER(tid), tw); FFT_SYNC(); } while (0)
namespace att {
constexpr float SCALE = 0.088388347648318440f;
constexpr float THR = 8.f;
#define KSWZ(row, colB) ((row) * 256 + ((colB) ^ (((row) & 7) << 4)))
#define SBAR() __builtin_amdgcn_sched_barrier(0)
__device__ __forceinline__ int crow(int r, int hi) { return (r & 3) + 8 * (r >> 2) + 4 * hi; }
__device__ __forceinline__ unsigned cvtpk(float lo, float hi) {
  unsigned r; asm volatile("v_cvt_pk_bf16_f32 %0, %1, %2" : "=v"(r) : "v"(lo), "v"(hi)); return r;
}
__device__ __forceinline__ void partialSM(f32x16& p0, f32x16& p1, float& m_reg, float& mn, float& alpha) {
  constexpr float C = SCALE * 1.4426950408889634f;
  float pmax = p0[0]; for (int r = 1; r < 16; ++r) pmax = fmaxf(pmax, p0[r]); for (int r = 0; r < 16; ++r) pmax = fmaxf(pmax, p1[r]);
  { auto rr = __builtin_amdgcn_permlane32_swap(__float_as_uint(pmax), __float_as_uint(pmax), false, false);
    pmax = fmaxf(__uint_as_float(rr[0]), __uint_as_float(rr[1])); }
  if (__builtin_expect(__all(pmax - m_reg <= THR / SCALE), 1)) { mn = m_reg; alpha = 1.f; }
  else { mn = fmaxf(m_reg, pmax); alpha = __builtin_amdgcn_exp2f((m_reg - mn) * C); m_reg = mn; }
  float mnC = -mn * C;
  for (int r = 0; r < 16; ++r) p0[r] = fmaf(p0[r], C, mnC); for (int r = 0; r < 16; ++r) p1[r] = fmaf(p1[r], C, mnC);
  for (int r = 0; r < 16; ++r) p0[r] = __builtin_amdgcn_exp2f(p0[r]);
}
__device__ __forceinline__ void finishSM(f32x16& p0, f32x16& p1, float alpha, float& l_reg, bf16x8& pa0, bf16x8& pa1, bf16x8& pa2, bf16x8& pa3) {
  for (int r = 0; r < 16; ++r) p1[r] = __builtin_amdgcn_exp2f(p1[r]);
  float ps = 0; for (int r = 0; r < 16; ++r) ps += p0[r]; for (int r = 0; r < 16; ++r) ps += p1[r];
  { auto rr = __builtin_amdgcn_permlane32_swap(__float_as_uint(ps), __float_as_uint(ps), false, false);
    ps = __uint_as_float(rr[0]) + __uint_as_float(rr[1]); }
  l_reg = l_reg * alpha + ps;
#define PK4(P, BASE, OUT) do { unsigned a0 = cvtpk(P[BASE + 0], P[BASE + 1]), a1 = cvtpk(P[BASE + 2], P[BASE + 3]);   \
    unsigned b0 = cvtpk(P[BASE + 4], P[BASE + 5]), b1 = cvtpk(P[BASE + 6], P[BASE + 7]);                              \
    auto r0 = __builtin_amdgcn_permlane32_swap(a0, b0, false, false); auto r1 = __builtin_amdgcn_permlane32_swap(a1, b1, false, false); \
    u32x4 w = {r0[0], r1[0], r0[1], r1[1]}; OUT = *reinterpret_cast<bf16x8*>(&w); } while (0)
  PK4(p0, 0, pa0); PK4(p0, 8, pa1); PK4(p1, 0, pa2); PK4(p1, 8, pa3);
#undef PK4
}
__device__ __forceinline__ void qkt(f32x16& p0, f32x16& p1, const char* Ks, const bf16x8* qr, int r32, int hi) {
  p0 = f32x16{}; p1 = f32x16{};
  for (int d0 = 0; d0 < 8; ++d0) { int cb = (d0 * 16 + hi * 8) * 2;
    bf16x8 b0 = *reinterpret_cast<const bf16x8*>((const char*)Ks + KSWZ(r32, cb));
    bf16x8 b1 = *reinterpret_cast<const bf16x8*>((const char*)Ks + KSWZ(32 + r32, cb));
    p0 = __builtin_amdgcn_mfma_f32_32x32x16_bf16(b0, qr[d0], p0, 0, 0, 0);
    p1 = __builtin_amdgcn_mfma_f32_32x32x16_bf16(b1, qr[d0], p1, 0, 0, 0); }
}
__device__ __forceinline__ int v_st(int k, int c) { const int kk = (k & ~0xC) | ((k & 4) << 1) | ((k & 8) >> 1); return ((kk >> 3) * 4 + (c >> 5)) * 512 + ((kk & 7) * 32 + (c & 31)) * 2; }
__device__ __forceinline__ int v_rd_base(int lane) { return ((lane & 3) << 3) | (((lane >> 2) & 3) << 6) | (((lane >> 4) & 1) << 5) | (((lane >> 5) & 1) << 8); }
constexpr int v_rd_off(int d0, int ks, int half) { return d0 * 512 + ks * 4096 + half * 2048; }
template <int OFF> __device__ __forceinline__ s16x4 tr_read(int vb) {
  s16x4 r; asm volatile("ds_read_b64_tr_b16 %0, %1 offset:%2" : "=&v"(r) : "v"(vb), "i"(OFF) : "memory"); return r;
}
template <int D0> __device__ __forceinline__ void pv_one(f32x16& od, int vb, bf16x8 pa0, bf16x8 pa1, bf16x8 pa2, bf16x8 pa3) {
  const s16x4 l0 = tr_read<v_rd_off(D0, 0, 0)>(vb), h0 = tr_read<v_rd_off(D0, 0, 1)>(vb), l1 = tr_read<v_rd_off(D0, 1, 0)>(vb), h1 = tr_read<v_rd_off(D0, 1, 1)>(vb);
  const s16x4 l2 = tr_read<v_rd_off(D0, 2, 0)>(vb), h2 = tr_read<v_rd_off(D0, 2, 1)>(vb), l3 = tr_read<v_rd_off(D0, 3, 0)>(vb), h3 = tr_read<v_rd_off(D0, 3, 1)>(vb);
  asm volatile("s_waitcnt lgkmcnt(0)" ::: "memory"); SBAR();
#define PK(L, H) (bf16x8){L[0], L[1], L[2], L[3], H[0], H[1], H[2], H[3]}
  od = __builtin_amdgcn_mfma_f32_32x32x16_bf16(pa0, PK(l0, h0), od, 0, 0, 0);
  od = __builtin_amdgcn_mfma_f32_32x32x16_bf16(pa1, PK(l1, h1), od, 0, 0, 0);
  od = __builtin_amdgcn_mfma_f32_32x32x16_bf16(pa2, PK(l2, h2), od, 0, 0, 0);
  od = __builtin_amdgcn_mfma_f32_32x32x16_bf16(pa3, PK(l3, h3), od, 0, 0, 0);
#undef PK
}
__device__ __forceinline__ void pv_d0(f32x16* o, int vb, bf16x8 pa0, bf16x8 pa1, bf16x8 pa2, bf16x8 pa3) {
  pv_one<0>(o[0], vb, pa0, pa1, pa2, pa3); pv_one<1>(o[1], vb, pa0, pa1, pa2, pa3); pv_one<2>(o[2], vb, pa0, pa1, pa2, pa3); pv_one<3>(o[3], vb, pa0, pa1, pa2, pa3);
}

}
struct Args { const float* in[NIN]; float* out; unsigned char* ws; int ph_lo, ph_hi; };

#define PIN(i) (A.in[(i)])
#define WSA(T, off) ((T*)(A.ws + (off)))
#define LDS_WAIT() asm volatile("s_waitcnt lgkmcnt(0)" ::: "memory")

__device__ __forceinline__ float bfv(const u32x4& a, int i) { const unsigned w = a[i >> 1]; return (i & 1) ? bfhi(w) : bflo(w); }
__device__ __forceinline__ float silu_f(float x) { return x / (1.f + expf(-x)); }

__device__ __forceinline__ float block_sum(const Ctx& C, float v) {
    v = wave_sum(v); LAS float* red = (LAS float*)(C.lds + LDS_RED);
    __syncthreads(); if (C.lane == 0) red[C.wave] = v; __syncthreads();
    float s = 0.f;
#pragma unroll
    for (int w = 0; w < 8; ++w) s += red[w];
    return s;
}

__device__ __forceinline__ size_t tiled_off(int n, int k, int K) { return ((size_t)(n >> 8) * (K >> 6) + (k >> 6)) * 16384 + (size_t)((n & 255) * 64 + (k & 63)); }
__device__ __forceinline__ void transpose_item(const float* W, int K, int N, bf16* WT, LAS float* scr, int item, int lane) {
    const int nblk = N / 32, kb = item / nblk, nb = item % nblk, k0 = 64 * kb, n0 = 32 * nb;
#pragma unroll
    for (int i = 0; i < 8; ++i) { const int kk = 8 * i + (lane >> 3), nn = (lane & 7) * 4; const f32x4 v = *(const f32x4*)(W + (size_t)(k0 + kk) * N + n0 + nn);
        scr[kk * 33 + nn] = v.x; scr[kk * 33 + nn + 1] = v.y; scr[kk * 33 + nn + 2] = v.z; scr[kk * 33 + nn + 3] = v.w; }
    LDS_WAIT();
    const int c = lane & 7;
#pragma unroll
    for (int j = 0; j < 4; ++j) { const int n = (lane >> 3) + 8 * j; const LAS float* s = scr + (8 * c) * 33 + n;
        u32x4 o; o.x = pk2(s[0 * 33], s[1 * 33]); o.y = pk2(s[2 * 33], s[3 * 33]); o.z = pk2(s[4 * 33], s[5 * 33]); o.w = pk2(s[6 * 33], s[7 * 33]);
        *(u32x4*)(WT + tiled_off(n0 + n, k0 + 8 * c, K)) = o; }
    LDS_WAIT();
}
__device__ __forceinline__ void ph_pro_a(const Ctx& C, const Args& A) {
    LAS float* scr = (LAS float*)(C.lds + C.wave * 16384);
    const int gw = C.bid * 8 + C.wave, NGW = C.G * 8;
    constexpr int I_IN = (DM / 64) * (INW / 32), I_OUT = (DM / 64) * (DM / 32), I_UP = (DM / 64) * (MLPH / 32), I_DN = (MLPH / 64) * (DM / 32), I_L = I_IN + I_OUT + I_UP + I_DN;
    for (int it = gw; it < DEPTH * I_L; it += NGW) {
        const int l = it / I_L; int r = it % I_L; unsigned char* wl = A.ws + WS_WT + (size_t)l * WT_LAYER;
        if (r < I_IN) { transpose_item(PIN(I_WIN) + (size_t)l * DM * INW, DM, INW, (bf16*)(wl + WT_IN), scr, r, C.lane); continue; } r -= I_IN;
        if (r < I_OUT) { transpose_item(PIN(I_WOUT) + (size_t)l * DM * DM, DM, DM, (bf16*)(wl + WT_OUT), scr, r, C.lane); continue; } r -= I_OUT;
        if (r < I_UP) { transpose_item(PIN(I_WUP) + (size_t)l * DM * MLPH, DM, MLPH, (bf16*)(wl + WT_UP), scr, r, C.lane); continue; } r -= I_UP;
        transpose_item(PIN(I_WDOWN) + (size_t)l * MLPH * DM, MLPH, DM, (bf16*)(wl + WT_DOWN), scr, r, C.lane);
    }
    const int gt = C.bid * 512 + C.tid, NT = C.G * 512;
    for (int idx = gt; idx < DEPTH * 32768; idx += NT) {
        const int l = idx >> 15, rem = idx & 32767, nrow = rem >> 6, k8 = (rem & 63) * 8, g = nrow >> 7, d = nrow & 127, gk = k8 >> 7, c0 = k8 & 127;
        u32x4 o = (u32x4){0u, 0u, 0u, 0u};
        if (g == gk) { const float* w = PIN(I_POOLW) + ((size_t)(l * 4 + g) * 128 + c0) * 128 + d;
            o.x = pk2(w[0], w[128]); o.y = pk2(w[256], w[384]); o.z = pk2(w[512], w[640]); o.w = pk2(w[768], w[896]); }
        *(u32x4*)((bf16*)(A.ws + WS_WT + (size_t)l * WT_LAYER + WT_POOL) + tiled_off(nrow, k8, 512)) = o;
    }
    { const float* cin = PIN(I_C); const float* cctx = PIN(I_CCTX); const float* wmod = PIN(I_WMOD); float* modp = WSA(float, WS_MODP);
      for (int it = gw; it < DEPTH * 48 * 32; it += NGW) {
        const int l = it / 1536, rem = it % 1536, cg = rem >> 5, kc = rem & 31, col = cg * 256 + C.lane * 4, k = kc * 64 + C.lane;
        const float a0 = silu_f(cin[k]), a1 = silu_f(cin[DM + k]), a2 = silu_f(cctx[k]);
        f32x4 s0 = (f32x4){0.f, 0.f, 0.f, 0.f}, s1 = s0, s2 = s0; const float* wp = wmod + ((size_t)l * DM + kc * 64) * MODW + col;
#pragma unroll 8
        for (int kk = 0; kk < 64; ++kk) { const f32x4 w = *(const f32x4*)(wp + (size_t)kk * MODW);
            const float b0 = __shfl(a0, kk), b1 = __shfl(a1, kk), b2 = __shfl(a2, kk); s0 += w * b0; s1 += w * b1; s2 += w * b2; }
        float* o = modp + ((size_t)(l * 32 + kc) * 3) * MODW + col; *(f32x4*)o = s0; *(f32x4*)(o + MODW) = s1; *(f32x4*)(o + 2 * MODW) = s2;
      } }
    for (int idx = gt; idx < 256 * 32; idx += NT) { const int pos = idx >> 5, i = idx & 31; const float invf = powf(10000.0f, -(float)i / 32.0f), ang = (float)pos * invf;
        WSA(cf32, WS_ROPE)[idx] = make_cf32(cosf(ang), sinf(ang)); }
    for (int idx = gt; idx < FFT_TWN; idx += NT) { const int L = idx < FFT_TW1 ? 16384 : (idx < FFT_TW2 ? 1024 : 64), S = L / 16, r = idx - (idx < FFT_TW1 ? FFT_TW0 : (idx < FFT_TW2 ? FFT_TW1 : FFT_TW2));
        const int q = r / S + 1, j = r % S; const float x = -2.0f * (float)(j * q) / (float)L; WSA(cf32, WS_TW)[idx] = make_cf32(cospif(x), sinpif(x)); }
}
__device__ __forceinline__ void ph_pro_b(const Ctx& C, const Args& A) {
    const int gt = C.bid * 512 + C.tid, NT = C.G * 512; const float* modp = WSA(float, WS_MODP); float* mod = WSA(float, WS_MOD);
    for (int idx = gt; idx < DEPTH * 3 * MODW; idx += NT) { const int l = idx / (3 * MODW), rem = idx % (3 * MODW), s = rem / MODW, col = rem % MODW; float acc = PIN(I_BMOD)[l * MODW + col];
#pragma unroll 8
        for (int kc = 0; kc < 32; ++kc) acc += modp[((size_t)(l * 32 + kc) * 3 + s) * MODW + col];
        mod[idx] = acc; }
}

template <bool SRC_F32, bool DST_F32>
__device__ __forceinline__ void ph_rownorm(const Ctx& C, const Args& A, bool upd, const float* gpost, const float* gate,
                                           bool do_hx, const float* gpre, const float* shp, const float* scp, int nrows, int nslices) {
    const int gw = C.bid * 8 + C.wave, NGW = C.G * 8;
    const bf16* OX = WSA(bf16, WS_OX); bf16* HX = WSA(bf16, WS_HX); bf16* XB = WSA(bf16, WS_XB);
    const int c0 = 8 * C.lane;
#pragma unroll 1
    for (int s = 0; s < 3; ++s) {
        if (s == 2 && (gw & 3)) continue;
        const int rstep = s < 2 ? NGW : (NGW >> 2);
        const int rbeg = s < 2 ? s * SEQ + gw : NLAT + (gw >> 2), rend = s < 2 ? (s + 1) * SEQ : nrows;
        if (rbeg >= rend) continue;
        f32x4 gg[8], aa[8], sh[8];
#pragma unroll
        for (int m = 0; m < 8; ++m) { const int col = c0 + 512 * (m >> 1) + 4 * (m & 1);
            gg[m] = upd ? *(const f32x4*)(gpost + col) * *(const f32x4*)(gate + s * MODW + col) : (f32x4){0.f, 0.f, 0.f, 0.f};
            aa[m] = do_hx ? *(const f32x4*)(gpre + col) * (*(const f32x4*)(scp + s * MODW + col) + 1.f) : (f32x4){0.f, 0.f, 0.f, 0.f};
            sh[m] = do_hx ? *(const f32x4*)(shp + s * MODW + col) : (f32x4){0.f, 0.f, 0.f, 0.f}; }
#pragma unroll 1
        for (int r = rbeg; r < rend; r += rstep) {
            f32x4 xv[8];
            if (SRC_F32) { const float* xs = (s < 2 ? PIN(I_X) + (size_t)r * DM : PIN(I_CTX) + (size_t)(r - NLAT) * DM) + c0;
#pragma unroll
                for (int m = 0; m < 8; ++m) xv[m] = *(const f32x4*)(xs + 512 * (m >> 1) + 4 * (m & 1)); }
            else {
#pragma unroll
                for (int j = 0; j < 4; ++j) { const u32x4 w = *(const u32x4*)(XB + (size_t)r * DM + c0 + 512 * j);
                    xv[2 * j] = (f32x4){bflo(w.x), bfhi(w.x), bflo(w.y), bfhi(w.y)}; xv[2 * j + 1] = (f32x4){bflo(w.z), bfhi(w.z), bflo(w.w), bfhi(w.w)}; } }
            if (upd) {
                f32x4 ov[8]; float ss = 0.f;
                if (s < 2) {
#pragma unroll
                    for (int j = 0; j < 4; ++j) { const u32x4 w = *(const u32x4*)(OX + (size_t)r * DM + c0 + 512 * j);
                        ov[2 * j] = (f32x4){bflo(w.x), bfhi(w.x), bflo(w.y), bfhi(w.y)}; ov[2 * j + 1] = (f32x4){bflo(w.z), bfhi(w.z), bflo(w.w), bfhi(w.w)}; }
                } else {
                    const float* pp = WSA(float, WS_PART) + (size_t)(r - NLAT) * DM + c0;
#pragma unroll
                    for (int m = 0; m < 8; ++m) ov[m] = (f32x4){0.f, 0.f, 0.f, 0.f};
#pragma unroll 1
                    for (int ks = 0; ks < nslices; ++ks) {
#pragma unroll
                        for (int m = 0; m < 8; ++m) ov[m] += *(const f32x4*)(pp + (size_t)ks * NCTX * DM + 512 * (m >> 1) + 4 * (m & 1)); }
                }
#pragma unroll
                for (int m = 0; m < 8; ++m) ss += (ov[m].x * ov[m].x + ov[m].y * ov[m].y) + (ov[m].z * ov[m].z + ov[m].w * ov[m].w);
                const float rstd = rsqrtf(wave_sum(ss) * (1.f / DM) + EPS);
#pragma unroll
                for (int m = 0; m < 8; ++m) xv[m] += gg[m] * (ov[m] * rstd);
                if (DST_F32) {
#pragma unroll
                    for (int m = 0; m < 8; ++m) *(f32x4*)(A.out + (size_t)r * DM + c0 + 512 * (m >> 1) + 4 * (m & 1)) = xv[m]; }
                else {
#pragma unroll
                    for (int j = 0; j < 4; ++j) { u32x4 w; w.x = pk2(xv[2 * j].x, xv[2 * j].y); w.y = pk2(xv[2 * j].z, xv[2 * j].w); w.z = pk2(xv[2 * j + 1].x, xv[2 * j + 1].y); w.w = pk2(xv[2 * j + 1].z, xv[2 * j + 1].w);
                        *(u32x4*)(XB + (size_t)r * DM + c0 + 512 * j) = w;
                        xv[2 * j] = (f32x4){bflo(w.x), bfhi(w.x), bflo(w.y), bfhi(w.y)}; xv[2 * j + 1] = (f32x4){bflo(w.z), bfhi(w.z), bflo(w.w), bfhi(w.w)}; } }
            }
            if (do_hx) {
                float ss = 0.f;
#pragma unroll
                for (int m = 0; m < 8; ++m) ss += (xv[m].x * xv[m].x + xv[m].y * xv[m].y) + (xv[m].z * xv[m].z + xv[m].w * xv[m].w);
                const float rstd = rsqrtf(wave_sum(ss) * (1.f / DM) + EPS);
#pragma unroll
                for (int j = 0; j < 4; ++j) { const f32x4 h0 = (xv[2 * j] * rstd) * aa[2 * j] + sh[2 * j], h1 = (xv[2 * j + 1] * rstd) * aa[2 * j + 1] + sh[2 * j + 1];
                    u32x4 w; w.x = pk2(h0.x, h0.y); w.y = pk2(h0.z, h0.w); w.z = pk2(h1.x, h1.y); w.w = pk2(h1.z, h1.w);
                    *(u32x4*)(HX + (size_t)r * DM + c0 + 512 * j) = w; }
            }
        }
    }
}

__device__ __forceinline__ void ph_filter_mlp(const Ctx& C, const Args& A, int l) {
    LAS float* feats = (LAS float*)C.lds;
    LAS float* h1 = feats + 65 * 36;
    LAS unsigned short* h2h = (LAS unsigned short*)(h1 + 65 * 64);
    LAS unsigned short* h2l = h2h + 72 * 72;
    const float* w1 = PIN(I_HW1) + l * 33 * 64; const float* b1 = PIN(I_HB1) + l * 64; const float* f1 = PIN(I_HF1) + l * 64;
    const float* w2 = PIN(I_HW2) + l * 64 * 64; const float* b2 = PIN(I_HB2) + l * 64; const float* f2 = PIN(I_HF2) + l * 64;
    const float* w3 = PIN(I_HW3) + (size_t)l * 64 * 1024; float* fpart = WSA(float, WS_FPART); float* HF = WSA(float, WS_HF); float* HFC = WSA(float, WS_HFC);
    for (int it = C.bid; it < 256; it += C.G) {
        const int i0 = it * 64;
#pragma unroll 1
        for (int idx = C.tid; idx < 65 * 33; idx += 512) { const int p = idx / 33, f = idx % 33, n = p < 64 ? SEQ : CTXL, i = p < 64 ? i0 + p : it; float val;
            if (f == 0) val = (float)i / (float)(n - 1);
            else { const int j = (f - 1) & 15; const float fj = 1e-4f + (float)j * ((15.0f - 1e-4f) / 15.0f), om = (6.283185307179586f * (float)i) / (float)n, a = fj * om;
                val = (f <= 16) ? cosf(a) : -sinf(a); }
            feats[p * 36 + f] = val; }
        __syncthreads();
        { const int u = fft_launder(C.tid & 63); float wc[33];
#pragma unroll
          for (int f = 0; f < 33; ++f) wc[f] = w1[f * 64 + u];
          const float bu = b1[u], fu = f1[u];
#pragma unroll 1
          for (int p = C.tid >> 6; p < 65; p += 8) { float acc = bu;
#pragma unroll
              for (int f = 0; f < 33; ++f) acc += feats[p * 36 + f] * wc[f];
              h1[p * 64 + u] = sinf(fu * acc); } }
        __syncthreads();
        { const int u = fft_launder(C.tid & 63); float wc[64];
#pragma unroll
          for (int k = 0; k < 64; ++k) wc[k] = w2[k * 64 + u];
          const float bu = b2[u], fu = f2[u];
#pragma unroll 1
          for (int p = C.tid >> 6; p < 65; p += 8) { float acc = bu;
#pragma unroll
              for (int k4 = 0; k4 < 16; ++k4) { const f32x4 hv = *(const LAS f32x4*)(h1 + p * 64 + 4 * k4);
                  acc += hv.x * wc[4 * k4] + hv.y * wc[4 * k4 + 1] + hv.z * wc[4 * k4 + 2] + hv.w * wc[4 * k4 + 3]; }
              const float v = sinf(fu * acc); const unsigned vh = f2bf(v); h2h[p * 72 + u] = (unsigned short)vh; h2l[p * 72 + u] = (unsigned short)f2bf(v - bf2f((unsigned short)vh)); } }
        __syncthreads();
        {
          const int r32 = C.lane & 31, hi = C.lane >> 5, ob = fft_launder(C.wave * 128);
          const float min_decay = -3.0701134573253945f, max_decay = -15.350567286626973f;
#pragma unroll 1
          for (int mb = 0; mb < 4; ++mb) {
              bf16x8 Ah[4], Al[4];
              const unsigned widx = (unsigned)(hi * 8 * 1024 + ob + mb * 32 + r32);
#pragma unroll
              for (int kk = 0; kk < 4; ++kk) { u32x4 hw, lw;
#pragma unroll
                  for (int jj = 0; jj < 4; ++jj) { const float w0 = (w3 + (kk * 16 + 2 * jj) * 1024)[widx], w1 = (w3 + (kk * 16 + 2 * jj + 1) * 1024)[widx]; const unsigned h0 = f2bf(w0), h1b = f2bf(w1);
                      hw[jj] = h0 | (h1b << 16); lw[jj] = f2bf(w0 - bf2f((unsigned short)h0)) | (f2bf(w1 - bf2f((unsigned short)h1b)) << 16); }
                  Ah[kk] = __builtin_bit_cast(bf16x8, hw); Al[kk] = __builtin_bit_cast(bf16x8, lw); }
              float s[16];
#pragma unroll
              for (int r = 0; r < 16; ++r) s[r] = 0.f;
#pragma unroll 1
              for (int nb = 0; nb < 3; ++nb) {
                  const int prow = nb < 2 ? nb * 32 + r32 : 64;
                  f32x16 acc = {};
#pragma unroll
                  for (int kk = 0; kk < 4; ++kk) { const bf16x8 bh = *(const LAS bf16x8*)(h2h + prow * 72 + kk * 16 + hi * 8), bl = *(const LAS bf16x8*)(h2l + prow * 72 + kk * 16 + hi * 8);
                      acc = __builtin_amdgcn_mfma_f32_32x32x16_bf16(Ah[kk], bh, acc, 0, 0, 0);
                      acc = __builtin_amdgcn_mfma_f32_32x32x16_bf16(Ah[kk], bl, acc, 0, 0, 0);
                      acc = __builtin_amdgcn_mfma_f32_32x32x16_bf16(Al[kk], bh, acc, 0, 0, 0); }
                  if (nb < 2) { const int pp = nb * 32 + r32; const float t = (float)(i0 + pp) / (float)(SEQ - 1);
                      const unsigned hidx = (unsigned)((ob + mb * 32 + 4 * hi) * SEQ + i0 + pp);
#pragma unroll
                      for (int r = 0; r < 16; ++r) { const int o = ob + mb * 32 + att::crow(r, hi), c = o & 511;
                          const float delta = fabsf(min_decay + (float)c * ((max_decay - min_decay) / 511.0f)) * 1.4426950408889634f;
                          const float v = acc[r] * __builtin_amdgcn_exp2f(-t * delta); (HF + (size_t)att::crow(r, 0) * SEQ)[hidx] = v; s[r] += fabsf(v); } }
                  else if (r32 == 0) { const float t = (float)it / (float)(CTXL - 1);
#pragma unroll
                      for (int r = 0; r < 16; ++r) { const int o = ob + mb * 32 + att::crow(r, hi), c = o & 511;
                          const float delta = fabsf(min_decay + (float)c * ((max_decay - min_decay) / 511.0f)) * 1.4426950408889634f;
                          const float v = acc[r] * __builtin_amdgcn_exp2f(-t * delta); HFC[(size_t)o * CTXL + it] = v; fpart[(256 + it) * 1024 + o] = fabsf(v); } }
              }
#pragma unroll
              for (int r = 0; r < 16; ++r) { float x = s[r];
#pragma unroll
                  for (int off = 1; off < 32; off <<= 1) x += __shfl_xor(x, off);
                  if (r32 == 0) fpart[it * 1024 + ob + mb * 32 + att::crow(r, hi)] = x; }
          } }
        __syncthreads();
    }
}
__device__ __forceinline__ int fft_freq_of(int p) { return (p >> 10) + 16 * ((p >> 6) & 15) + 256 * ((p >> 2) & 15) + 4096 * (p & 3); }
__device__ __forceinline__ int fft_pos_of(int f) { return 1024 * (f & 15) + 64 * ((f >> 4) & 15) + 4 * ((f >> 8) & 15) + (f >> 12); }
__device__ __forceinline__ void ph_filter_fft(const Ctx& C, const Args& A, int extra, int d) {
    LAS cf32* buf = (LAS cf32*)C.lds; const float* HF = WSA(float, WS_HF); const float* FP = WSA(float, WS_FPART); cf32* SPEC = WSA(cf32, WS_SPEC); const cf32* tw = WSA(cf32, WS_TW);
    const cf32 wstep = make_cf32(cospif(-1.0f / SEQ), sinpif(-1.0f / SEQ));
    constexpr int NIT = 512;
    const int nlow = C.G - extra, nA = (nlow * d < NIT) ? nlow * d : 0, dA = nA ? d : 0;
    const int myA = (C.bid >= extra) ? dA : 0, nB = NIT - nA, myB = (nB - C.bid + C.G - 1) / C.G > 0 ? (nB - C.bid + C.G - 1) / C.G : 0;
#pragma unroll 1
    for (int k = 0; k < myA + myB; ++k) {
        const int it = k < myA ? (C.bid - extra) + nlow * k : nA + C.bid + C.G * (k - myA);
        const int c0 = it >> 1, c1 = c0 + 256, e = it & 1;
        const float part0 = C.tid < 256 ? FP[C.tid * 1024 + c0] + FP[C.tid * 1024 + 512 + c0] : 0.f, part1 = C.tid < 256 ? FP[C.tid * 1024 + c1] + FP[C.tid * 1024 + 512 + c1] : 0.f;
        const float inv0 = 1.f / block_sum(C, part0), inv1 = 1.f / block_sum(C, part1);
        const float* hf0 = HF + (size_t)c0 * SEQ; const float* hb0 = HF + (size_t)(512 + c0) * SEQ; const float* hf1 = HF + (size_t)c1 * SEQ; const float* hb1 = HF + (size_t)(512 + c1) * SEQ;
#pragma unroll 2
        for (int q = 0; q < 8; ++q) { const int t0 = (C.tid + 512 * q) * 4; const f32x4 a0 = *(const f32x4*)(hf0 + t0), a1 = *(const f32x4*)(hf1 + t0);
            cf32 w = make_cf32(1.f, 0.f); if (e) { const float x = -(float)t0 * (1.0f / SEQ); w = make_cf32(cospif(x), sinpif(x)); }
#pragma unroll
            for (int i = 0; i < 4; ++i) { const int t = t0 + i, tb = (t == 0) ? 0 : SEQ - t; const float b0 = hb0[tb], b1 = hb1[tb]; cf32 v;
                if (e == 0 || t == 0) v = make_cf32((a0[i] + b0) * inv0, (a1[i] + b1) * inv1); else v = cmul(make_cf32((a0[i] - b0) * inv0, (a1[i] - b1) * inv1), w);
                buf[fpad(t)] = v; if (e) w = cmul(w, wstep); } }
        __syncthreads();
        FFT_FORWARD(buf, C.tid, tw);
        cf32* sp0 = SPEC + (size_t)(c0 * 2 + e) * SEQ; cf32* sp1 = SPEC + (size_t)(c1 * 2 + e) * SEQ;
#pragma unroll 2
        for (int q = 0; q < 16; ++q) { const int p0 = (C.tid + 512 * q) * 2; f32x4 o0, o1;
#pragma unroll
            for (int i = 0; i < 2; ++i) { const int p = p0 + i, f = fft_freq_of(p), fm = e ? (SEQ - 1 - f) : ((SEQ - f) & (SEQ - 1)), pm = fft_pos_of(fm);
                const cf32 zf = buf[fpad(p)], zm = buf[fpad(pm)], zc = make_cf32(zm.x, -zm.y), ka = (zf + zc) * 0.5f, dd = (zf - zc) * 0.5f;
                o0[2 * i] = ka.x; o0[2 * i + 1] = ka.y; o1[2 * i] = dd.y; o1[2 * i + 1] = -dd.x; }
            *(f32x4*)(sp0 + p0) = o0; *(f32x4*)(sp1 + p0) = o1; }
        __syncthreads();
    }
}
template <int E, int VAR = 0> __device__ __forceinline__ void conv_half(const Ctx& C, LAS cf32* buf, const bf16* v0, const bf16* v1, const cf32* sp, const cf32* tw, cf32 (&ya)[32], float* y0, float* y1) {
    const int tidl = fft_launder(C.tid);
    const cf32 wstep = make_cf32(cospif(-1.0f / SEQ), sinpif(-1.0f / SEQ));
#pragma unroll 1
    for (int k = 0; k < 4; ++k) { const int t0 = (tidl + 512 * k) * 8; const u32x4 a = *(const u32x4*)(v0 + t0), b = *(const u32x4*)(v1 + t0);
        cf32 w = make_cf32(1.f, 0.f); if (E) { const float x = -(float)t0 * (1.0f / SEQ); w = make_cf32(cospif(x), sinpif(x)); }
#pragma unroll
        for (int i = 0; i < 8; ++i) { cf32 z = make_cf32(bfv(a, i), bfv(b, i)); if (E) { z = cmul(z, w); w = cmul(w, wstep); } buf[fpad(t0 + i)] = z; } }
    __syncthreads();
    if (VAR != 1) { fft_pass16<16384, false>(buf, FFT_LAUNDER(tidl), tw); FFT_SYNC(); fft_pass16<1024, false>(buf, FFT_LAUNDER(tidl), tw); FFT_SYNC(); fft_pass16<64, false>(buf, FFT_LAUNDER(tidl), tw); FFT_SYNC(); }
#pragma unroll 2
    for (int k = 0; k < 8; ++k) { const int p0 = (tidl + 512 * k) * 4, b0 = fpad(p0); const f32x4 s0 = *(const f32x4*)(sp + p0), s1 = *(const f32x4*)(sp + p0 + 2);
        cf32 a = buf[b0], b = buf[b0 + 1], c = buf[b0 + 2], d = buf[b0 + 3];
        dft4<false>(a, b, c, d);
        a = cmul(a, make_cf32(s0.x, s0.y)); b = cmul(b, make_cf32(s0.z, s0.w)); c = cmul(c, make_cf32(s1.x, s1.y)); d = cmul(d, make_cf32(s1.z, s1.w));
        dft4<true>(a, b, c, d);
        buf[b0] = a; buf[b0 + 1] = b; buf[b0 + 2] = c; buf[b0 + 3] = d; }
    FFT_SYNC();
    if (VAR != 1) { fft_pass16<64, true>(buf, FFT_LAUNDER(tidl), tw); FFT_SYNC(); fft_pass16<1024, true>(buf, FFT_LAUNDER(tidl), tw); FFT_SYNC(); fft_pass16<16384, true>(buf, FFT_LAUNDER(tidl), tw); FFT_SYNC(); }
    if (E == 0) {
#pragma unroll
        for (int k = 0; k < 8; ++k) { const int t0 = (tidl + 512 * k) * 4;
#pragma unroll
            for (int i = 0; i < 4; ++i) ya[4 * k + i] = buf[fpad(t0 + i)]; } }
    else {
        const cf32 wstepc = make_cf32(wstep.x, -wstep.y);
#pragma unroll
        for (int k = 0; k < 8; ++k) { const int t0 = (tidl + 512 * k) * 4; const float x = (float)t0 * (1.0f / SEQ); cf32 w = make_cf32(cospif(x), sinpif(x));
            f32x4 o0, o1; const float sc = 1.0f / (2 * SEQ);
#pragma unroll
            for (int i = 0; i < 4; ++i) { const cf32 yb = cmul(buf[fpad(t0 + i)], w); w = cmul(w, wstepc); o0[i] = (ya[4 * k + i].x + yb.x) * sc; o1[i] = (ya[4 * k + i].y + yb.y) * sc; }
            *(f32x4*)(y0 + t0) = o0; *(f32x4*)(y1 + t0) = o1; asm volatile("" ::: "memory"); } }
    __syncthreads();
}
template <int VAR = 0> __device__ __forceinline__ void ph_conv(const Ctx& C, const Args& A) {
    LAS cf32* buf = (LAS cf32*)C.lds; const bf16* VT = WSA(bf16, WS_VT); float* YT = WSA(float, WS_YT); const cf32* SPEC = WSA(cf32, WS_SPEC); const cf32* tw = WSA(cf32, WS_TW);
#pragma unroll 1
    for (int c = C.bid; c < HYW; c += C.G) {
        const bf16* v0 = VT + (size_t)c * MROWS; const bf16* v1 = v0 + SEQ; float* y0 = YT + (size_t)c * MROWS; cf32 ya[32];
        conv_half<0, VAR>(C, buf, v0, v1, SPEC + (size_t)(c * 2) * SEQ, tw, ya, y0, y0 + SEQ);
        conv_half<1, VAR>(C, buf, v0, v1, SPEC + (size_t)(c * 2 + 1) * SEQ, tw, ya, y0, y0 + SEQ);
    }
}
__device__ __forceinline__ void ph_conv_ctx(const Ctx& C, const Args& A) {
    LAS float* taps = (LAS float*)C.lds; LAS float* vb = taps + 512;
    const float* HFC = WSA(float, WS_HFC); const float* FP = WSA(float, WS_FPART); const bf16* VT = WSA(bf16, WS_VT); float* YT = WSA(float, WS_YT);
    for (int c = C.bid; c < HYW; c += C.G) {
        const float part = C.tid < 256 ? FP[(256 + C.tid) * 1024 + c] + FP[(256 + C.tid) * 1024 + 512 + c] : 0.f;
        const float inv = 1.f / block_sum(C, part);
        if (C.tid < 511) { const int d = C.tid - 255; const float k = d > 0 ? HFC[(size_t)c * CTXL + d] : (d < 0 ? HFC[(size_t)(512 + c) * CTXL - d] : HFC[(size_t)c * CTXL] + HFC[(size_t)(512 + c) * CTXL]);
            taps[C.tid] = k * inv; }
        vb[C.tid] = bf2f(VT[(size_t)c * MROWS + NLAT + C.tid]);
        __syncthreads();
        const int b = C.tid >> 8, t = C.tid & 255; float acc = 0.f;
#pragma unroll 8
        for (int s = 0; s < CTXL; ++s) acc += taps[t - s + 255] * vb[b * CTXL + s];
        YT[(size_t)c * MROWS + NLAT + C.tid] = acc;
        __syncthreads();
    }
}

__device__ __forceinline__ void seq_of_row(int r, int& seq0, int& seqlen) { if (r < NLAT) { seq0 = r & ~(SEQ - 1); seqlen = SEQ; } else { seq0 = NLAT + ((r - NLAT) & ~(CTXL - 1)); seqlen = CTXL; } }
__device__ __forceinline__ void ph_krope(const Ctx& C, const Args& A) {
    const int gt = C.bid * 512 + C.tid, NT = C.G * 512; bf16* PX = WSA(bf16, WS_PX); const cf32* ROPE = WSA(cf32, WS_ROPE);
    for (int idx = gt; idx < NLAT * 16; idx += NT) { const int r = idx >> 4, sub = idx & 15, kvh = sub >> 3, half = (sub >> 2) & 1, q = sub & 3, t = r & (SEQ - 1), pos = half ? (t & 63) : (t >> 6);
        bf16* p = PX + (size_t)r * INW + Q_END + kvh * 128 + half * 64 + q * 8; const u32x4 a = *(const u32x4*)p, b = *(const u32x4*)(p + 32); const cf32* rt = ROPE + pos * 32 + q * 8;
        float n1[8], n2[8];
#pragma unroll
        for (int i = 0; i < 8; ++i) { const float x1 = bfv(a, i), x2 = bfv(b, i); const cf32 cs = rt[i]; n1[i] = x1 * cs.x - x2 * cs.y; n2[i] = x2 * cs.x + x1 * cs.y; }
        u32x4 oa, ob; oa.x = pk2(n1[0], n1[1]); oa.y = pk2(n1[2], n1[3]); oa.z = pk2(n1[4], n1[5]); oa.w = pk2(n1[6], n1[7]);
        ob.x = pk2(n2[0], n2[1]); ob.y = pk2(n2[2], n2[3]); ob.z = pk2(n2[4], n2[5]); ob.w = pk2(n2[6], n2[7]);
        *(u32x4*)p = oa; *(u32x4*)(p + 32) = ob; }
}
__device__ __forceinline__ void ph_hyena_pre(const Ctx& C, const Args& A, int l, int nrows) {
    LAS unsigned short* tile = (LAS unsigned short*)C.lds;
    const bf16* PX = WSA(bf16, WS_PX); bf16* VT = WSA(bf16, WS_VT);
    const float* cw = PIN(I_HCW) + l * 3 * 1536; const float* cb = PIN(I_HCB) + l * 1536;
    const int ct = C.bid & 7, c8 = (C.tid & 7) * 8, ch = ct * 64 + c8, tt = C.tid >> 3;
    float wx[3][8], wv[3][8], bx[8], bv[8];
#pragma unroll
    for (int i = 0; i < 8; ++i) { bx[i] = cb[512 + ch + i]; bv[i] = cb[1024 + ch + i];
#pragma unroll
        for (int d = 0; d < 3; ++d) { wx[d][i] = cw[d * 1536 + 512 + ch + i]; wv[d][i] = cw[d * 1536 + 1024 + ch + i]; } }
    u32x4 ra[3], rb[3], na[3], nb[3];
#define HP_LOAD(TL, DA, DB) do { const int r0_ = (TL) * 64; int s0_, sl_; seq_of_row(r0_, s0_, sl_); const int r_ = r0_ + tt, tin_ = r_ - s0_; \
        _Pragma("unroll") for (int d = 0; d < 3; ++d) { const bool ok_ = (tin_ + d - 1 >= 0) && (tin_ + d - 1 < sl_); const bf16* p_ = PX + (size_t)(r_ + d - 1) * INW + V_END + ch; \
            DA[d] = ok_ ? *(const u32x4*)(p_ + 512) : (u32x4){0u, 0u, 0u, 0u}; DB[d] = ok_ ? *(const u32x4*)(p_ + 1024) : (u32x4){0u, 0u, 0u, 0u}; } } while (0)
    int tl = C.bid >> 3; const int tstep = C.G >> 3;
    const int ntl = nrows / 64;
    if (tl < ntl) HP_LOAD(tl, ra, rb);
#pragma unroll 1
    for (; tl < ntl; tl += tstep) {
        const int r0 = tl * 64;
        if (tl + tstep < ntl) HP_LOAD(tl + tstep, na, nb);
        float x1[8], vv[8];
#pragma unroll
        for (int i = 0; i < 8; ++i) { x1[i] = bx[i]; vv[i] = bv[i]; }
#pragma unroll
        for (int d = 0; d < 3; ++d) {
#pragma unroll
            for (int i = 0; i < 8; ++i) { x1[i] += bfv(ra[d], i) * wx[d][i]; vv[i] += bfv(rb[d], i) * wv[d][i]; } }
#pragma unroll
        for (int i = 0; i < 8; ++i) tile[(c8 + i) * 72 + tt] = (unsigned short)f2bf(x1[i] * vv[i]);
        __syncthreads();
        const int cc = C.tid >> 3, t8 = (C.tid & 7) * 8;
        const u32x4 o = *(const LAS u32x4*)(tile + cc * 72 + t8);
        *(u32x4*)(VT + (size_t)(ct * 64 + cc) * MROWS + r0 + t8) = o;
        __syncthreads();
#pragma unroll
        for (int d = 0; d < 3; ++d) { ra[d] = na[d]; rb[d] = nb[d]; }
    }
#undef HP_LOAD
}
__device__ __forceinline__ void ph_pool_pre(const Ctx& C, const Args& A, int nrows) {
    LAS u32x4* st = (LAS u32x4*)C.lds;
    const bf16* PX = WSA(bf16, WS_PX); bf16* PO = WSA(bf16, WS_POOLED);
    for (int tl = C.bid; tl < nrows / 64; tl += C.G) {
        const int r0 = tl * 64; int seq0, seqlen; seq_of_row(r0, seq0, seqlen); const int tin0 = r0 - seq0;
#pragma unroll
        for (int k = 0; k < 10; ++k) { const int idx = C.tid + 512 * k, rr = idx >> 6, ck = idx & 63, tin = tin0 - 8 + rr;
            st[idx] = (tin >= 0 && tin < seqlen) ? *(const u32x4*)(PX + (size_t)(seq0 + tin) * INW + HY_END + ck * 8) : (u32x4){0u, 0u, 0u, 0u}; }
        __syncthreads();
#pragma unroll 1
        for (int k = 0; k < 8; ++k) { const int idx = C.tid + 512 * k, tt = idx >> 6, ck = idx & 63, g = ck >> 4, h = 1 << g, tin = tin0 + tt;
            float s[8];
#pragma unroll
            for (int i = 0; i < 8; ++i) s[i] = 0.f;
            for (int q = tt + 8 - h; q < tt + 8 + h; ++q) { const u32x4 a = st[q * 64 + ck];
#pragma unroll
                for (int i = 0; i < 8; ++i) s[i] += bfv(a, i); }
            const u32x4 xs = st[(tt + 8) * 64 + ck]; const int lo = tin - h > 0 ? tin - h : 0, hi = tin + h < seqlen ? tin + h : seqlen; const float invc = 1.f / (float)(hi - lo); float o[8];
#pragma unroll
            for (int i = 0; i < 8; ++i) o[i] = s[i] * invc - bfv(xs, i);
            u32x4 w; w.x = pk2(o[0], o[1]); w.y = pk2(o[2], o[3]); w.z = pk2(o[4], o[5]); w.w = pk2(o[6], o[7]);
            *(u32x4*)(PO + (size_t)(r0 + tt) * 512 + ck * 8) = w; }
        __syncthreads();
    }
}
__device__ __forceinline__ void ph_attention(const Ctx& C, const Args& A, int l, bool do_ctx) {
    using namespace att;
    const bf16* PX = WSA(bf16, WS_PX); bf16* MG = WSA(bf16, WS_MERGED); const cf32* ROPE = WSA(cf32, WS_ROPE);
    char* LB = C.ldsg; float* wsf = (float*)(C.ldsg + 131072) + C.wave * 64; float* li_l = wsf; float* al_l = wsf + 32;
    const int tid = C.tid, lane = C.lane, wid = C.wave, r32 = lane & 31, hi = lane >> 5;
    const int sr = tid >> 4, sc = (tid & 15) * 8, vst0 = v_st(sr, sc), vst1 = v_st(32 + sr, sc);
    const int vbase = (int)(uintptr_t)LB + v_rd_base(lane);
    unsigned doff[8];
#pragma unroll
    for (int q = 0; q < 8; ++q) { const int pc = wid + 8 * q, region = pc >> 4, ob = (pc & 15) * 1024 + lane * 16;
        int key, col;
        if (region >= 2) { const int row = ob >> 8; key = (region & 1) * 64 + row; col = ((ob & 255) ^ ((row & 7) << 4)) >> 1; }
        else { const int sub = ob >> 9, e = (ob & 511) >> 1, kk = (sub >> 2) * 8 + (e >> 5), k = (kk & ~0xC) | ((kk & 4) << 1) | ((kk & 8) >> 1); key = (region & 1) * 64 + k; col = 256 + (sub & 3) * 32 + (e & 31); }
        doff[q] = (unsigned)(key * INW + col) * 2u; }
    const int nlat_u = (1024 - C.bid + C.G - 1) / C.G, nctx_u = (do_ctx && C.bid >= C.G - 16) ? 1 : 0;
#pragma unroll 1
    for (int ui = 0; ui < nlat_u + nctx_u; ++ui) {
        const int unit = ui < nlat_u ? 16 + C.bid + C.G * ui : C.G - 1 - C.bid;
        bool isctx; int b, qb, kvh, hp;
        if (unit < 16) { isctx = true; b = unit >> 3; kvh = (unit >> 2) & 1; hp = (unit >> 1) & 1; qb = unit & 1; }
        else { const int u = unit - 16; isctx = false; hp = u & 1; kvh = (u >> 1) & 1; qb = (u >> 2) & 127; b = u >> 9; }
        const int hq = kvh * 4 + hp * 2 + (wid >> 2), t = qb * 128 + (wid & 3) * 32 + r32;
        const size_t seqrow0 = isctx ? (size_t)(NLAT + b * CTXL) : (size_t)b * SEQ;
        const size_t ctxrow0 = (size_t)(NLAT + b * CTXL);
        const int blo = isctx ? 0 : (qb == 0 ? 1 : 0), bhi = isctx ? 0 : (qb == SEQ / 128 - 1 ? 2 : 3), nband = bhi - blo, nst = nband + 2;
#define ATT_BASE(i) ((const char*)(PX + ((i) < nband ? seqrow0 + (size_t)(128 * (qb - 1 + blo + (i))) : ctxrow0 + (size_t)(128 * ((i) - nband))) * INW + Q_END + kvh * 128))
#define ATT_DMA(i) do { const char* gb_ = ATT_BASE(i); LAS unsigned char* lb_ = C.lds + ((i) & 1) * 65536 + wid * 1024; \
        _Pragma("unroll") for (int q_ = 0; q_ < 8; ++q_) __builtin_amdgcn_global_load_lds((const unsigned*)(gb_ + doff[q_]), (LAS unsigned*)(lb_ + q_ * 8192), 16, 0, 0); } while (0)
        __syncthreads();
        ATT_DMA(0);
        bf16x8 qr[8];
        { const bf16* qp = PX + (seqrow0 + t) * INW + hq * 128 + hi * 8;
#pragma unroll
          for (int d0 = 0; d0 < 8; ++d0) qr[d0] = *(const bf16x8*)(qp + d0 * 16);
          if (!isctx) {
#pragma unroll
            for (int hf = 0; hf < 2; ++hf) { const int pos = hf ? (t & 63) : (t >> 6);
#pragma unroll
                for (int dd = 0; dd < 2; ++dd) { const int d0 = hf * 4 + dd; const cf32* rt = ROPE + pos * 32 + dd * 16 + hi * 8; bf16x8 a = qr[d0], bq = qr[d0 + 2];
#pragma unroll
                    for (int j = 0; j < 8; ++j) { const float x1 = bf2f((unsigned short)a[j]), x2 = bf2f((unsigned short)bq[j]); const cf32 cs = rt[j];
                        a[j] = (short)f2bf(x1 * cs.x - x2 * cs.y); bq[j] = (short)f2bf(x2 * cs.x + x1 * cs.y); }
                    qr[d0] = a; qr[d0 + 2] = bq; } } } }
        float m_reg = PIN(I_SINK)[l * 8 + hq] * (1.0f / SCALE), l_reg = 1.f; f32x16 o[4] = {};
#pragma unroll 1
        for (int i = 0; i < nst; ++i) {
            char* buf = LB + (i & 1) * 65536;
            asm volatile("s_waitcnt vmcnt(0)" ::: "memory"); __syncthreads();
            if (i + 1 < nst) ATT_DMA(i + 1);
            const int blk = blo + i; const bool masked = (i < nband) && (blk != 1);
#pragma unroll 1
            for (int hh = 0; hh < 2; ++hh) {
                const int s0 = 128 * (qb - 1 + blk) + 64 * hh;
                if (masked && ((blk == 0 && hh == 0 && (wid & 3) >= 2) || (blk == 2 && hh == 1 && (wid & 3) < 2))) continue;
                f32x16 p0, p1; qkt(p0, p1, buf + 32768 + hh * 16384, qr, r32, hi);
                if (masked) {
                    const bool prev = (blk == 0); const int base = t - s0 - 4 * hi, u0 = prev ? base : -base;
#pragma unroll
                    for (int r = 0; r < 16; ++r) { const int cr = (r & 3) + 8 * (r >> 2); const int th0 = prev ? 128 + cr : 128 - cr, th1 = prev ? 160 + cr : 96 - cr;
                        if (u0 > th0) p0[r] = -1e30f; if (u0 > th1) p1[r] = -1e30f; }
                }
                float mn, alpha; partialSM(p0, p1, m_reg, mn, alpha);
                if (__any(alpha < 1.f)) { if (hi == 0) al_l[r32] = alpha; asm volatile("s_waitcnt lgkmcnt(0)" ::: "memory");
#pragma unroll
                    for (int d = 0; d < 4; ++d)
#pragma unroll
                        for (int r = 0; r < 16; ++r) o[d][r] *= al_l[crow(r, hi)]; }
                bf16x8 pa0, pa1, pa2, pa3; finishSM(p0, p1, alpha, l_reg, pa0, pa1, pa2, pa3); SBAR();
                pv_d0(o, vbase + (i & 1) * 65536 + hh * 16384, pa0, pa1, pa2, pa3);
            }
        }
#undef ATT_BASE
#undef ATT_DMA
        if (hi == 0) li_l[r32] = l_reg; asm volatile("s_waitcnt lgkmcnt(0)" ::: "memory");
        { char* tb = LB + (nst & 1) * 65536 + wid * 8192;
#pragma unroll
          for (int r = 0; r < 16; ++r) { const int orow = crow(r, hi); const float rl = __builtin_amdgcn_rcpf(li_l[orow]);
#pragma unroll
              for (int d0 = 0; d0 < 4; ++d0) *(bf16*)(tb + orow * 256 + (d0 * 32 + r32) * 2) = (bf16)f2bf(o[d0][r] * rl); }
          asm volatile("s_waitcnt lgkmcnt(0)" ::: "memory");
          bf16* Ow = MG + (seqrow0 + qb * 128 + (wid & 3) * 32) * DM + hq * 128;
#pragma unroll
          for (int k = 0; k < 8; ++k) { const int q = lane + 64 * k, row = q >> 4, ch = q & 15;
              *(u32x4*)(Ow + (size_t)row * DM + ch * 8) = *(const u32x4*)(tb + row * 256 + ch * 16); } }
    }
    __syncthreads();
}

__device__ __forceinline__ void ph_mix_post(const Ctx& C, const Args& A, int l, bool do_attn, int nrows) {
    LAS float* ytile = (LAS float*)C.lds;
    LAS float* vtile = ytile + 32 * 516;
    const bf16* PX = WSA(bf16, WS_PX); bf16* MG = WSA(bf16, WS_MERGED); const bf16* PR = WSA(bf16, WS_PORAW); const bf16* VT = WSA(bf16, WS_VT); const float* YT = WSA(float, WS_YT);
    const float* cw = PIN(I_HCW) + l * 3 * 1536; const float* cb = PIN(I_HCB) + l * 1536; const float* hbias = PIN(I_HBIAS) + l * 512; const float* psc = PIN(I_POOLS) + l * 512; const float* gbr = PIN(I_GBRANCH) + l * DM;
    const int c0 = C.lane * 8;
    float r_cb[8], r_cw[3][8], r_hb[8], r_gh[8], r_ps[8], r_gp[8], r_ga[16];
#pragma unroll
    for (int i = 0; i < 8; ++i) { r_cb[i] = cb[c0 + i]; r_hb[i] = hbias[c0 + i]; r_gh[i] = gbr[1024 + c0 + i]; r_ps[i] = psc[c0 + i]; r_gp[i] = gbr[1536 + c0 + i];
        r_cw[0][i] = cw[c0 + i]; r_cw[1][i] = cw[1536 + c0 + i]; r_cw[2][i] = cw[3072 + c0 + i]; }
#pragma unroll
    for (int i = 0; i < 16; ++i) r_ga[i] = gbr[C.lane * 16 + i];
    for (int it = C.bid; it < nrows / 32; it += C.G) {
        const int r0 = it * 32; int seq0, seqlen; seq_of_row(r0, seq0, seqlen);
#pragma unroll
        for (int k = 0; k < 8; ++k) { const int c = (C.tid >> 3) + 64 * k, t4 = (C.tid & 7) * 4; const f32x4 y = *(const f32x4*)(YT + (size_t)c * MROWS + r0 + t4);
            ytile[(t4 + 0) * 516 + c] = y.x; ytile[(t4 + 1) * 516 + c] = y.y; ytile[(t4 + 2) * 516 + c] = y.z; ytile[(t4 + 3) * 516 + c] = y.w; }
#pragma unroll
        for (int k = 0; k < 4; ++k) { const int c = (C.tid >> 2) + 128 * k, t8 = (C.tid & 3) * 8; const u32x4 v = *(const u32x4*)(VT + (size_t)c * MROWS + r0 + t8);
#pragma unroll
            for (int i = 0; i < 8; ++i) vtile[(t8 + i) * 516 + c] = bfv(v, i); }
        __syncthreads();
#pragma unroll 1
        for (int q = 0; q < 4; ++q) {
            const int tt = C.wave * 4 + q, r = r0 + tt, tin = r - seq0;
            { float x0[8], hy[8];
#pragma unroll
              for (int i = 0; i < 8; ++i) x0[i] = r_cb[i];
#pragma unroll
              for (int dt = -1; dt <= 1; ++dt) { if (tin + dt < 0 || tin + dt >= seqlen) continue;
                  const u32x4 a = *(const u32x4*)(PX + (size_t)(r + dt) * INW + V_END + c0);
#pragma unroll
                  for (int i = 0; i < 8; ++i) x0[i] += bfv(a, i) * r_cw[dt + 1][i]; }
              const f32x4 ya = *(const LAS f32x4*)(ytile + tt * 516 + c0), yb = *(const LAS f32x4*)(ytile + tt * 516 + c0 + 4);
              const f32x4 va = *(const LAS f32x4*)(vtile + tt * 516 + c0), vb = *(const LAS f32x4*)(vtile + tt * 516 + c0 + 4);
              float ss = 0.f;
#pragma unroll
              for (int i = 0; i < 8; ++i) { const float y = i < 4 ? ya[i] : yb[i - 4], v = i < 4 ? va[i] : vb[i - 4]; hy[i] = (y + v * r_hb[i]) * x0[i]; ss += hy[i] * hy[i]; }
              const float rstd = rsqrtf(wave_sum(ss) * (1.f / HYW) + EPS); const float* g = r_gh;
              u32x4 w; w.x = pk2(hy[0] * rstd * g[0], hy[1] * rstd * g[1]); w.y = pk2(hy[2] * rstd * g[2], hy[3] * rstd * g[3]);
              w.z = pk2(hy[4] * rstd * g[4], hy[5] * rstd * g[5]); w.w = pk2(hy[6] * rstd * g[6], hy[7] * rstd * g[7]);
              *(u32x4*)(MG + (size_t)r * DM + 1024 + c0) = w; }
            { const u32x4 a = *(const u32x4*)(PR + (size_t)r * 512 + c0); float po[8]; float ss = 0.f;
#pragma unroll
              for (int i = 0; i < 8; ++i) { po[i] = bfv(a, i) * r_ps[i]; ss += po[i] * po[i]; }
              const float rstd = rsqrtf(wave_sum(ss) * (1.f / PLW) + EPS); const float* g = r_gp;
              u32x4 w; w.x = pk2(po[0] * rstd * g[0], po[1] * rstd * g[1]); w.y = pk2(po[2] * rstd * g[2], po[3] * rstd * g[3]);
              w.z = pk2(po[4] * rstd * g[4], po[5] * rstd * g[5]); w.w = pk2(po[6] * rstd * g[6], po[7] * rstd * g[7]);
              *(u32x4*)(MG + (size_t)r * DM + 1536 + c0) = w; }
            if (do_attn) { bf16* ap = MG + (size_t)r * DM + C.lane * 16; const u32x4 a = *(const u32x4*)ap, b = *(const u32x4*)(ap + 8); float av[16]; float ss = 0.f;
#pragma unroll
              for (int i = 0; i < 8; ++i) { av[i] = bfv(a, i); av[8 + i] = bfv(b, i); }
#pragma unroll
              for (int i = 0; i < 16; ++i) ss += av[i] * av[i];
              const float rstd = rsqrtf(wave_sum(ss) * (1.f / 1024.f) + EPS); const float* g = r_ga;
              u32x4 w0, w1; w0.x = pk2(av[0] * rstd * g[0], av[1] * rstd * g[1]); w0.y = pk2(av[2] * rstd * g[2], av[3] * rstd * g[3]);
              w0.z = pk2(av[4] * rstd * g[4], av[5] * rstd * g[5]); w0.w = pk2(av[6] * rstd * g[6], av[7] * rstd * g[7]);
              w1.x = pk2(av[8] * rstd * g[8], av[9] * rstd * g[9]); w1.y = pk2(av[10] * rstd * g[10], av[11] * rstd * g[11]);
              w1.z = pk2(av[12] * rstd * g[12], av[13] * rstd * g[13]); w1.w = pk2(av[14] * rstd * g[14], av[15] * rstd * g[15]);
              *(u32x4*)ap = w0; *(u32x4*)(ap + 8) = w1; }
        }
        __syncthreads();
    }
}
constexpr int NPHASES = 2 + 10 + 9 * (DEPTH - 1);
__device__ __forceinline__ Ctx fresh(const Ctx& C) { Ctx R = C; R.tid = fft_launder(C.tid); R.lane = R.tid & 63; return R; }
#define CL fresh(C)
#ifndef PROBE_GEMM
#define PROBE_GEMM 0
#endif
#ifndef PROBE_FFT
#define PROBE_FFT 0
#endif
#ifndef PROBE_MLP
#define PROBE_MLP 0
#endif
#ifndef PROBE_FFTF
#define PROBE_FFTF 0
#endif
#if PROBE_MLP
#define MLP_REP(...) __VA_ARGS__ __VA_ARGS__
#else
#define MLP_REP(...) __VA_ARGS__
#endif
#if PROBE_FFTF
#define FFTF_REP(...) __VA_ARGS__ __VA_ARGS__
#else
#define FFTF_REP(...) __VA_ARGS__
#endif
#ifndef PROBE_MP
#define PROBE_MP 0
#endif
#ifndef PROBE_RN
#define PROBE_RN 0
#endif
#if PROBE_MP
#define MP_REP(...) __VA_ARGS__
#else
#define MP_REP(...)
#endif
#if PROBE_RN
#define RN_REP(...) __VA_ARGS__
#else
#define RN_REP(...)
#endif
#ifndef WGM_DOWN
#define WGM_DOWN 4
#endif
#ifndef WGM_IN
#define WGM_IN 4
#endif
#ifndef WGM_OUT
#define WGM_OUT 4
#endif
#ifndef WGM_UP
#define WGM_UP 4
#endif
#ifndef PROBE_WIN
#define PROBE_WIN 0
#endif
#ifndef PROBE_GD0
#define PROBE_GD0 0
#endif
#ifndef PROBE_GU
#define PROBE_GU 0
#endif
#ifndef PROBE_GD
#define PROBE_GD 0
#endif
#if PROBE_GU || PROBE_GEMM
#define GEMMU_REP(...) __VA_ARGS__ __syncthreads(); __VA_ARGS__
#else
#define GEMMU_REP(...) __VA_ARGS__
#endif
#if PROBE_GD || PROBE_GEMM
#define GEMMD_REP(...) __VA_ARGS__ __syncthreads(); __VA_ARGS__
#else
#define GEMMD_REP(...) __VA_ARGS__
#endif
#ifndef PROBE_ATT
#define PROBE_ATT 0
#endif
#ifndef PROBE_PRE
#define PROBE_PRE 0
#endif
#if PROBE_GEMM
#define GEMM_REP(...) __VA_ARGS__ __syncthreads(); __VA_ARGS__
#else
#define GEMM_REP(...) __VA_ARGS__
#endif
#if PROBE_FFT
#define FFT_REP(...) __VA_ARGS__ __VA_ARGS__
#else
#define FFT_REP(...) __VA_ARGS__
#endif
#if PROBE_ATT
#define ATT_REP(...) __VA_ARGS__ __VA_ARGS__
#else
#define ATT_REP(...) __VA_ARGS__
#endif
#if PROBE_PRE
#define PRE_REP(...) __VA_ARGS__ __VA_ARGS__
#else
#define PRE_REP(...) __VA_ARGS__
#endif
#ifndef TPROBE
#define TPROBE 0
#endif
#ifndef MIX_SWAP
#define MIX_SWAP 0
#endif
#if TPROBE
#define TP_TS ((unsigned long long*)(A.ws + WS_CTL + 131072))
#define TP_MK ((unsigned long long*)(A.ws + WS_CTL + 262144))
#define TP_MARK(id, k) if (C.tid == 0) TP_MK[((id) * 4 + (k)) * 256 + C.bid] = __builtin_amdgcn_s_memrealtime();
#define TP_KIND(p) ((p) < 3 ? (p) : 3 + ((p) - 3) % 9)
#ifndef TP_SEL
#define TP_SEL(p) 1
#endif
#ifndef TP_MODE
#define TP_MODE 1
#endif
#ifndef TP_SCALE
#define TP_SCALE 4
#endif
#ifndef TP_K0
#define TP_K0 0
#define TP_K1 1
#endif
#else
#define TP_MARK(id, k)
#endif
__global__ void __launch_bounds__(512, 2) trunk_fwd(Args A) {
    extern __shared__ __attribute__((aligned(16))) unsigned char lds_raw[];
    Ctx C;
    C.lds = (LAS unsigned char*)lds_raw; C.ldsg = (char*)lds_raw;
    C.tid = threadIdx.x; C.lane = C.tid & 63; C.wave = __builtin_amdgcn_readfirstlane(C.tid >> 6); C.bid = blockIdx.x; C.G = gridDim.x;
    volatile LAS unsigned* MISC = (volatile LAS unsigned*)(C.lds + LDS_MISC);
    if (C.tid < 64) MISC[C.tid] = 0u;
    __syncthreads();
    unsigned* barw = (unsigned*)(A.ws + WS_CTL) + 4096;
    XcdBarrier bar; bar.bar = barw; bar.x = 0; bar.st = nullptr;
#if !MK_PER_PHASE
    bar = xcd_barrier_post(barw, MISC);
#endif
    const int lo = A.ph_lo, hi = A.ph_hi;
#if MK_PER_PHASE
#define PH_END(id) }
#elif TPROBE
#define PH_END(id) if (C.tid == 0) TP_TS[((id) + 1) * 256 + C.bid] = __builtin_amdgcn_s_memrealtime(); xcd_barrier(bar); }
#else
#define PH_END(id) if ((id) + 1 < hi) xcd_barrier(bar); }
#endif
#if TPROBE
    if (C.tid == 0) TP_TS[C.bid] = __builtin_amdgcn_s_memrealtime();
#endif
#define PH_BEGIN(id) if (lo <= (id) && (id) < hi) {
    const float* MOD = WSA(float, WS_MOD);
    PH_BEGIN(0) ph_pro_a(CL, A); PH_END(0)
    PH_BEGIN(1) ph_pro_b(CL, A); PH_END(1)
    int id = 2;
#pragma unroll 1
    for (int l = 0; l < DEPTH; ++l) {
        const float* modl = MOD + (size_t)l * 3 * MODW; const bool last = (l == DEPTH - 1); const int mrows = last ? NLAT : MROWS;
        unsigned char* wl = A.ws + WS_WT + (size_t)l * WT_LAYER;
        if (l == 0) {
            PH_BEGIN(id) MLP_REP(ph_filter_mlp(CL, A, 0);)
                ph_rownorm<true, false>(CL, A, false, nullptr, nullptr, true, PIN(I_GPREMIX), modl + 0 * DM, modl + 1 * DM, MROWS, 0); PH_END(id)
            ++id;
        }
        PH_BEGIN(id)
#if PROBE_WIN
            { pg8::Gemm g{WSA(bf16, WS_HX), (const bf16*)(wl + WT_IN), PROBE_WIN, INW, DM, DM, 0, 1}; pg8::RevOrder S; S.init(PROBE_WIN, INW, C.G, C.bid, WGM_IN);
              pg8::EpiOut<0> E{WSA(bf16, WS_PX), INW, 0}; pg8::gemm_phase<pg8::EpiOut<0>, pg8::RevOrder, true, true>(C.lds, g, S, E); } __syncthreads();
#endif
            GEMM_REP({ pg8::Gemm g{WSA(bf16, WS_HX), (const bf16*)(wl + WT_IN), MROWS, INW, DM, DM, 0, 1}; pg8::RevOrder S; S.init(MROWS, INW, C.G, C.bid, WGM_IN);
            pg8::EpiOut<0> E{WSA(bf16, WS_PX), INW, 0}; pg8::gemm_phase<pg8::EpiOut<0>, pg8::RevOrder, true, true>(C.lds, g, S, E); })
            FFTF_REP(ph_filter_fft(CL, A, ((MROWS / 256) * (INW / 256)) % C.G, 2);) PH_END(id)
        ++id;
        PH_BEGIN(id) ph_krope(CL, A); PRE_REP(ph_hyena_pre(CL, A, l, mrows); ph_pool_pre(CL, A, mrows);) PH_END(id)
        ++id;
        PH_BEGIN(id) TP_MARK(id, 0)
#if MIX_SWAP
#pragma unroll 1
            for (int st = 0; st < 2; ++st) { if ((((C.bid >> 3) ^ st) & 1) == 0) { ph_conv<0>(CL, A); if (!last) ph_conv_ctx(CL, A); } else ph_attention(CL, A, l, !last); }
#else
            FFT_REP(ph_conv<0>(CL, A); if (!last) ph_conv_ctx(CL, A);) TP_MARK(id, 1) ATT_REP(ph_attention(CL, A, l, !last);) TP_MARK(id, 2)
#endif
            GEMM_REP({ pg8::Gemm g{WSA(bf16, WS_POOLED), (const bf16*)(wl + WT_POOL), mrows, 512, 512, 512, 0, 1}; pg8::StaticOrder S; S.init(mrows, 512, C.G, C.bid);
              pg8::EpiOut<0> E{WSA(bf16, WS_PORAW), 512, 0}; pg8::gemm_phase<pg8::EpiOut<0>, pg8::StaticOrder, true, true>(C.lds, g, S, E); }) TP_MARK(id, 3) PH_END(id)
        ++id;
        PH_BEGIN(id) MP_REP(ph_mix_post(CL, A, l, false, mrows);) ph_mix_post(CL, A, l, true, mrows); PH_END(id)
        ++id;
        PH_BEGIN(id) GEMM_REP({ pg8::Gemm g{WSA(bf16, WS_MERGED), (const bf16*)(wl + WT_OUT), NLAT, DM, DM, DM, 0, 1}; pg8::RevOrder S; S.init(NLAT, DM, C.G, C.bid, WGM_OUT);
            pg8::EpiOut<0> E{WSA(bf16, WS_OX), DM, 0}; pg8::gemm_phase<pg8::EpiOut<0>, pg8::RevOrder, true, true>(C.lds, g, S, E); })
            if (!last) { pg8::Gemm g{WSA(bf16, WS_MERGED) + (size_t)NLAT * DM, (const bf16*)(wl + WT_OUT), NCTX, DM, 256, DM, 0, 1}; pg8::SplitOrder S; S.init(NCTX, DM, 8, 256, C.G, C.bid);
                pg8::EpiPart E{WSA(float, WS_PART), DM, (size_t)NCTX * DM}; pg8::gemm_phase<pg8::EpiPart, pg8::SplitOrder, true, true>(C.lds, g, S, E); } PH_END(id)
        ++id;
        PH_BEGIN(id)
            if (l == 0) ph_rownorm<true, false>(CL, A, true, PIN(I_GPOSTMIX) + l * DM, modl + 2 * DM, true, PIN(I_GPREMLP) + l * DM, modl + 3 * DM, modl + 4 * DM, mrows, 8);
            else ph_rownorm<false, false>(CL, A, true, PIN(I_GPOSTMIX) + l * DM, modl + 2 * DM, true, PIN(I_GPREMLP) + l * DM, modl + 3 * DM, modl + 4 * DM, mrows, 8);
        PH_END(id)
        ++id;
        PH_BEGIN(id) GEMMU_REP({ pg8::Gemm g{WSA(bf16, WS_HX), (const bf16*)(wl + WT_UP), mrows, MLPH, DM, DM, 0, 1}; pg8::RevOrder S; S.init(mrows, MLPH, C.G, C.bid, WGM_UP);
            pg8::EpiOut<1> E{WSA(bf16, WS_H), MLPH, 1}; pg8::gemm_phase<pg8::EpiOut<1>, pg8::RevOrder, true, true>(C.lds, g, S, E); }) PH_END(id)
        ++id;
        PH_BEGIN(id)
#if PROBE_GD0
            { pg8::Gemm g{WSA(bf16, WS_H), (const bf16*)(wl + WT_DOWN), NLAT, DM, MLPH, MLPH, 1, 1}; pg8::FakeOrder S; S.init(NLAT, DM, C.G, C.bid);
              pg8::EpiOut<0> E{WSA(bf16, WS_OX), DM, 0}; pg8::gemm_phase<pg8::EpiOut<0>, pg8::FakeOrder, true, true>(C.lds, g, S, E); } __syncthreads();
#endif
            GEMMD_REP({ pg8::Gemm g{WSA(bf16, WS_H), (const bf16*)(wl + WT_DOWN), NLAT, DM, MLPH, MLPH, 1, 1}; pg8::StaticOrder S; S.init(NLAT, DM, C.G, C.bid, WGM_DOWN);
            pg8::EpiOut<0> E{WSA(bf16, WS_OX), DM, 0}; pg8::gemm_phase<pg8::EpiOut<0>, pg8::StaticOrder, true, true>(C.lds, g, S, E); })
            if (!last) { pg8::Gemm g{WSA(bf16, WS_H) + (size_t)NLAT * MLPH, (const bf16*)(wl + WT_DOWN), NCTX, DM, 512, MLPH, 1, 1}; pg8::SplitOrder S; S.init(NCTX, DM, 16, 512, C.G, C.bid);
                pg8::EpiPart E{WSA(float, WS_PART), DM, (size_t)NCTX * DM}; pg8::gemm_phase<pg8::EpiPart, pg8::SplitOrder, true, true>(C.lds, g, S, E); } PH_END(id)
        ++id;
        PH_BEGIN(id)
            if (l + 1 < DEPTH) { const float* modn = modl + 3 * MODW;
                ph_rownorm<false, false>(CL, A, true, PIN(I_GPOSTMLP) + l * DM, modl + 5 * DM, true, PIN(I_GPREMIX) + (l + 1) * DM, modn + 0 * DM, modn + 1 * DM, MROWS, 16);
                MLP_REP(ph_filter_mlp(CL, A, l + 1);) }
            else ph_rownorm<false, true>(CL, A, true, PIN(I_GPOSTMLP) + l * DM, modl + 5 * DM, false, nullptr, nullptr, nullptr, NLAT, 0);
        PH_END(id)
        ++id;
    }
#undef PH_BEGIN
#undef PH_END
#if TPROBE
    if (C.bid == 0 && C.wave == 0) {
        const volatile unsigned long long* ts = TP_TS;
        const unsigned long long t0 = ts[0];
        float metric = 0.f, prevmax = 0.f;
#pragma unroll 1
        for (int p = 0; p <= NPHASES; ++p) {
            float mx = -1e30f, sm = 0.f;
            for (int k = 0; k < 4; ++k) { const float v = (float)(long long)(ts[p * 256 + C.lane + 64 * k] - t0); mx = fmaxf(mx, v); sm += v; }
            for (int o = 32; o; o >>= 1) { mx = fmaxf(mx, __shfl_xor(mx, o)); sm += __shfl_xor(sm, o); }
            if (TP_MODE == 2) { if (p > 0 && (TP_SEL((p - 1)))) { float dm = 0.f;
                    for (int k = 0; k < 4; ++k) dm += (float)(long long)(TP_MK[((p - 1) * 4 + TP_K1) * 256 + C.lane + 64 * k] - TP_MK[((p - 1) * 4 + TP_K0) * 256 + C.lane + 64 * k]);
                    for (int o = 32; o; o >>= 1) dm += __shfl_xor(dm, o);
                    metric += dm * (1.f / 256.f); } }
            else
            if (p > 0 && (TP_SEL((p - 1)))) metric += TP_MODE ? (mx - sm * (1.f / 256.f)) : (mx - prevmax);
            prevmax = mx;
        }
        const unsigned long long spin = (unsigned long long)(metric * TP_SCALE), tb = __builtin_amdgcn_s_memrealtime();
        while (__builtin_amdgcn_s_memrealtime() - tb < spin) __builtin_amdgcn_s_sleep(8);
    }
#endif
}

extern "C" void kernel_launch(void* const* d_in, const int* in_sizes, int n_in, void* d_out, int out_size, void* d_ws, size_t ws_size, hipStream_t stream) {
    static int grid = 0;
    if (grid == 0) {
        if (n_in != NIN || in_sizes[0] != NLAT * DM || out_size != NLAT * DM || ws_size < WS_END) {
            fprintf(stderr, "kernel_launch: shape mismatch: n_in %d in0 %d out %d ws %zu (need %zu); nothing launched\n", n_in, n_in > 0 ? in_sizes[0] : -1, out_size, ws_size, (size_t)WS_END); grid = -1; return; }
        int dev = 0, cus = 0, per_cu = 0;
        if (hipGetDevice(&dev) != hipSuccess || hipDeviceGetAttribute(&cus, hipDeviceAttributeMultiprocessorCount, dev) != hipSuccess) { fprintf(stderr, "kernel_launch: device query failed\n"); grid = -1; return; }
        if (hipFuncSetAttribute((const void*)trunk_fwd, hipFuncAttributeMaxDynamicSharedMemorySize, LDS_BYTES) != hipSuccess) { fprintf(stderr, "kernel_launch: hipFuncSetAttribute failed\n"); grid = -1; return; }
        if (hipOccupancyMaxActiveBlocksPerMultiprocessor(&per_cu, (const void*)trunk_fwd, 512, LDS_BYTES) != hipSuccess || per_cu < 1)
            fprintf(stderr, "kernel_launch: note: occupancy query reports %d workgroups per CU\n", per_cu);
        (void)hipGetLastError();
        grid = (cus < 256 ? cus : 256) & ~7;
    }
    if (grid < 0) return;
    if (hipMemsetAsync((char*)d_ws + WS_CTL, 0, CTL_ZERO_BYTES, stream) != hipSuccess) { fprintf(stderr, "kernel_launch: memset failed\n"); return; }
    Args a{};
    for (int i = 0; i < NIN; ++i) a.in[i] = (const float*)d_in[i];
    a.out = (float*)d_out; a.ws = (unsigned char*)d_ws;
#if MK_PER_PHASE
    for (int ph = 0; ph < NPHASES; ++ph) { a.ph_lo = ph; a.ph_hi = ph + 1;
        hipLaunchKernelGGL(trunk_fwd, dim3(grid), dim3(512), LDS_BYTES, stream, a); }
#else
    a.ph_lo = 0; a.ph_hi = NPHASES;
    hipLaunchKernelGGL(trunk_fwd, dim3(grid), dim3(512), LDS_BYTES, stream, a);
#endif
    const hipError_t le = hipPeekAtLastError();
    if (le != hipSuccess) fprintf(stderr, "kernel_launch: launch failed: %s\n", hipGetErrorName(le));
}
```

```cpp
#include <hip/hip_runtime.h>
#include <cstdio>
#include <cstdint>
#include <type_traits>
#ifndef MK_PER_PHASE
#define MK_PER_PHASE 0
#endif
#ifndef PG8_AUX_A
#define PG8_AUX_A 0
#endif
namespace pg8 {
#define PG8_LAS __attribute__((address_space(3)))
typedef unsigned short bf16_t;
typedef short bf16x8 __attribute__((ext_vector_type(8)));
typedef float f32x4 __attribute__((ext_vector_type(4)));
typedef unsigned u32x4 __attribute__((ext_vector_type(4)));
constexpr int BM = 256, BK = 64, HALF = 128, HTB = HALF * BK * 2  , STAGE_BYTES = 8 * HTB, NXCD = 8, WGM = 8;

__host__ __device__ __forceinline__ int lds_byte(int r, int c) { const int st = (r >> 4) * 2 + (c >> 5), rr = r & 15, cc = c & 31, ob = rr * 64 + cc * 2; return st * 1024 + (ob ^ (((ob >> 9) & 1) << 5)); }
__host__ __device__ __forceinline__ void stage_rc(int b, int& R, int& C) { const int st = b / 1024, sb = b % 1024, swz = sb ^ (((sb >> 9) & 1) << 5); R = (st >> 1) * 16 + swz / 64; C = (st & 1) * 32 + (swz % 64) / 2; }
__host__ __device__ __forceinline__ int perm32(int rho) { const int n = rho >> 4, i = rho & 15; return 8 * (i >> 2) + 4 * n + (i & 3); }

__device__ __forceinline__ int pg8_tid() { int t = threadIdx.x; asm volatile("" : "+v"(t)); return t; }
struct Unit { int pm, pn, ko, ks; };
struct Gemm { const bf16_t* A; const bf16_t* Bt; int M, N, K, ld, tiledA, tiledB; };

struct StaticOrder {
    int nM, nN, nwg, G, c, wgm;
    __host__ __device__ void init(int M, int N, int G_, int c_, int wgm_ = WGM) { nM = M / BM; nN = N / BM; nwg = nM * nN; G = G_; c = c_; wgm = wgm_; }
    __host__ __device__ bool next(int i, Unit& u) const {
        const long L = (long)i * G + c; if (L >= nwg) return false;
        int wgid = (int)L; { const int q = nwg / NXCD, r = nwg % NXCD, xcd = wgid % NXCD, off = wgid / NXCD; wgid = (xcd < r ? xcd * (q + 1) : r * (q + 1) + (xcd - r) * q) + off; }
        const int nig = wgm * nN, gid = wgid / nig, fm = gid * wgm, gsz = (nM - fm) < wgm ? (nM - fm) : wgm;
        u.pm = fm + ((wgid % nig) % gsz); u.pn = (wgid % nig) / gsz; u.ko = 0; u.ks = -1; return true;
    }
    __device__ __forceinline__ void a_ready(const Unit&) const {}
    __device__ __forceinline__ void done(const Unit&) const {}
};
struct FakeOrder : StaticOrder { __host__ __device__ bool next(int i, Unit& u) const { const bool ok = StaticOrder::next(i, u); u.pm = 0; u.pn = 0; return ok; } };
struct RevOrder : StaticOrder { __host__ __device__ bool next(int i, Unit& u) const { const bool ok = StaticOrder::next(i, u); u.pm = nM - 1 - u.pm; return ok; } };
struct SplitOrder {
    int nM, ntile, nsub, ksub, G, c;
    __host__ __device__ void init(int M, int N, int nslices, int ksub_, int G_, int c_) { nM = M / BM; ntile = nM * (N / BM); nsub = ntile * nslices; ksub = ksub_; G = G_; c = c_; }
    __host__ __device__ bool next(int i, Unit& u) const { const long L = (long)i * G + c; if (L >= nsub) return false; const int s = (int)L, tile = s % ntile, ks = s / ntile;
        u.pm = tile % nM; u.pn = tile / nM; u.ko = ks * ksub; u.ks = ks; return true; }
    __device__ __forceinline__ void a_ready(const Unit&) const {}
    __device__ __forceinline__ void done(const Unit&) const {}
};
__device__ __forceinline__ unsigned cvt_pk_bf16(float lo, float hi) { unsigned r; asm volatile("v_cvt_pk_bf16_f32 %0, %1, %2" : "=v"(r) : "v"(lo), "v"(hi)); return r; }
template <int ACT> struct EpiOut {
    static constexpr bool PERM = true, AFTER_DRAIN = false;
    bf16_t* O; int ldc; int tiled;
    __device__ __forceinline__ void operator()(const f32x4 (&acc)[2][2][4][2], const Unit& u, int wr, int wc, int fr, int fq) const {
        const int row0 = u.pm * BM + wr * 64 + fr; const int col0 = u.pn * BM + wc * 32 + 8 * fq;
#pragma unroll
        for (int ai = 0; ai < 2; ++ai)
#pragma unroll
            for (int m = 0; m < 4; ++m) { const int row = row0 + ai * HALF + m * 16; bf16_t* rowp = O + (size_t)row * ldc + col0;
#pragma unroll
                for (int bj = 0; bj < 2; ++bj) { f32x4 v0 = acc[ai][bj][m][0], v1 = acc[ai][bj][m][1];
                    if (ACT == 1) {
#pragma unroll
                        for (int j = 0; j < 4; ++j) { const float a = v0[j] > 0.f ? v0[j] : 0.f, b = v1[j] > 0.f ? v1[j] : 0.f; v0[j] = a * a; v1[j] = b * b; } }
                    u32x4 w; w.x = cvt_pk_bf16(v0[0], v0[1]); w.y = cvt_pk_bf16(v0[2], v0[3]); w.z = cvt_pk_bf16(v1[0], v1[1]); w.w = cvt_pk_bf16(v1[2], v1[3]);
                    if (tiled) { const int col = col0 + bj * HALF; *(u32x4*)(O + ((size_t)(row >> 8) * (ldc >> 6) + (col >> 6)) * 16384 + (size_t)((row & 255) * 64 + (col & 63))) = w; }
                    else *(u32x4*)(rowp + bj * HALF) = w; } }
    }
};
struct EpiPart {
    static constexpr bool PERM = false, AFTER_DRAIN = false;
    float* P; int ldc; size_t slice_stride;
    __device__ __forceinline__ void operator()(const f32x4 (&acc)[2][2][4][2], const Unit& u, int wr, int wc, int fr, int fq) const {
        const int row0 = u.pm * BM + wr * 64 + fr, col0 = u.pn * BM + wc * 32 + 4 * fq; float* base = P + (size_t)u.ks * slice_stride;
#pragma unroll
        for (int ai = 0; ai < 2; ++ai)
#pragma unroll
            for (int m = 0; m < 4; ++m) { float* rowp = base + (size_t)(row0 + ai * HALF + m * 16) * ldc + col0;
#pragma unroll
                for (int bj = 0; bj < 2; ++bj)
#pragma unroll
                    for (int n = 0; n < 2; ++n) *(f32x4*)(rowp + bj * HALF + n * 16) = acc[ai][bj][m][n]; }
    }
};
template <class Epi, class Sched, bool ALIGN_EPI = false, bool SP2 = false>
__device__ __forceinline__ void gemm_phase(PG8_LAS unsigned char* lds, const Gemm g, const Sched& S, const Epi& E) {
    const int tid = pg8_tid(), wid = __builtin_amdgcn_readfirstlane(tid >> 6), lane = tid & 63, wr = wid >> 2, wc = wid & 3, fr = lane & 15, fq = lane >> 4;
    const int K = g.ld, nt = g.K / BK;
    unsigned voffA[2], voffB[2];
#pragma unroll
    for (int i = 0; i < 2; ++i) { int R, C; stage_rc(tid * 16 + i * 8192, R, C); const int Rb = Epi::PERM ? ((R & ~31) + perm32(R & 31)) : R;
        voffA[i] = g.tiledA ? (unsigned)(R * BK + C) * 2u : (unsigned)(R * K + C) * 2u; voffB[i] = g.tiledB ? (unsigned)(Rb * BK + C) * 2u : (unsigned)(Rb * K + C) * 2u; }
    const size_t kstepA = g.tiledA ? (size_t)(BM * BK * 2) : (size_t)(BK * 2), kstepB = g.tiledB ? (size_t)(BM * BK * 2) : (size_t)(BK * 2);
    const size_t hstep = (size_t)HALF * K * 2, hstepA = g.tiledA ? (size_t)(HALF * BK * 2) : hstep, hstepB = g.tiledB ? (size_t)(HALF * BK * 2) : hstep;
    const size_t koA = g.tiledA ? (size_t)(BM * 2) : 2, koB = g.tiledB ? (size_t)(BM * 2) : 2;
    const size_t tstep = 2 * hstep;
    const unsigned ldsw = (unsigned)wid * 1024u;
    const int aoff = lds_byte(wr * 64 + fr, fq * 8), boff = lds_byte(wc * 32 + fr, fq * 8);
#define PG8_SA(b, h) (((b) * 2 + (h)) * HTB)
#define PG8_SB(b, h) ((4 + (b) * 2 + (h)) * HTB)
#define PG8_STAGE(bufoff, gbase, voff) do { _Pragma("unroll") for (int _i = 0; _i < 2; ++_i) \
        __builtin_amdgcn_global_load_lds((const unsigned*)((const char*)(gbase) + (voff)[_i]), (PG8_LAS unsigned*)(lds + (bufoff) + ldsw + _i * 8192), 16, 0, 0); } while (0)
#define PG8_LDA(dst, b, h) do { _Pragma("unroll") for (int m = 0; m < 4; ++m) _Pragma("unroll") for (int k = 0; k < 2; ++k) dst[m][k] = *(const PG8_LAS bf16x8*)(lds + PG8_SA(b, h) + aoff + m * 2048 + k * 1024); } while (0)
#define PG8_LDB(dst, b, h) do { _Pragma("unroll") for (int n = 0; n < 2; ++n) _Pragma("unroll") for (int k = 0; k < 2; ++k) dst[n][k] = *(const PG8_LAS bf16x8*)(lds + PG8_SB(b, h) + boff + n * 2048 + k * 1024); } while (0)
#define PG8_MMA(ai, bj, At, Bt) do { __builtin_amdgcn_s_setprio(1); _Pragma("unroll") for (int m = 0; m < 4; ++m) _Pragma("unroll") for (int n = 0; n < 2; ++n) _Pragma("unroll") for (int k = 0; k < 2; ++k) \
        acc[ai][bj][m][n] = __builtin_amdgcn_mfma_f32_16x16x32_bf16(Bt[n][k], At[m][k], acc[ai][bj][m][n], 0, 0, 0); __builtin_amdgcn_s_setprio(0); } while (0)
#define PG8_WAIT_V(n) asm volatile("s_waitcnt vmcnt(" #n ")" ::: "memory")
#define PG8_WAIT_L(n) asm volatile("s_waitcnt lgkmcnt(" #n ")" ::: "memory")
#define PG8_BAR __builtin_amdgcn_s_barrier()
#define PG8_SCHED __builtin_amdgcn_sched_barrier(0)
    Unit cur, nxt; int ui = 0;
    if (!S.next(0, cur)) return;
    f32x4 acc[2][2][4][2];
#pragma unroll
    for (int a = 0; a < 2; ++a)
#pragma unroll
        for (int b = 0; b < 2; ++b)
#pragma unroll
            for (int m = 0; m < 4; ++m)
#pragma unroll
                for (int n = 0; n < 2; ++n) acc[a][b][m][n] = (f32x4){0.f, 0.f, 0.f, 0.f};
    bf16x8 At[4][2], B0[2][2], B1[2][2];
    const char* cA = (const char*)g.A + (size_t)cur.pm * tstep + (size_t)cur.ko * koA; const char* cB = (const char*)g.Bt + (size_t)cur.pn * tstep + (size_t)cur.ko * koB;
    S.a_ready(cur);
    if constexpr (SP2) {
        PG8_STAGE(PG8_SB(0, 0), cB, voffB); PG8_STAGE(PG8_SB(0, 1), cB + hstepB, voffB); PG8_STAGE(PG8_SA(0, 0), cA, voffA); PG8_STAGE(PG8_SA(0, 1), cA + hstepA, voffA);
        if (wr == 1) PG8_BAR;
        PG8_WAIT_V(2); PG8_BAR;
        PG8_STAGE(PG8_SB(1, 0), cB + kstepB, voffB); PG8_STAGE(PG8_SA(1, 0), cA + kstepA, voffA); PG8_STAGE(PG8_SB(1, 1), cB + hstepB + kstepB, voffB);
        PG8_WAIT_V(6); PG8_BAR;
    } else {
        PG8_STAGE(PG8_SB(0, 0), cB, voffB); PG8_STAGE(PG8_SA(0, 0), cA, voffA); PG8_STAGE(PG8_SB(0, 1), cB + hstepB, voffB); PG8_STAGE(PG8_SA(0, 1), cA + hstepA, voffA);
        if (wr == 1) PG8_BAR;
        PG8_WAIT_V(4); PG8_BAR;
        PG8_STAGE(PG8_SB(1, 0), cB + kstepB, voffB); PG8_STAGE(PG8_SA(1, 0), cA + kstepA, voffA); PG8_STAGE(PG8_SB(1, 1), cB + hstepB + kstepB, voffB);
        PG8_WAIT_V(6); PG8_BAR;
    }
    for (;;) {
        const bool has_next = S.next(ui + 1, nxt);
        const char* nA = has_next ? (const char*)g.A + (size_t)nxt.pm * tstep + (size_t)nxt.ko * koA : cA; const char* nB = has_next ? (const char*)g.Bt + (size_t)nxt.pn * tstep + (size_t)nxt.ko * koB : cB;
        for (int t = 0; t < nt; t += 2) {
            const bool last = (t == nt - 2);
            const char* a1 = cA + (size_t)(t + 1) * kstepA;
            const char* a2 = last ? nA : cA + (size_t)(t + 2) * kstepA; const char* b2 = last ? nB : cB + (size_t)(t + 2) * kstepB;
            const char* a3 = a2 + kstepA; const char* b3 = b2 + kstepB;
            if (last && has_next) S.a_ready(nxt);
            if constexpr (SP2) {
            PG8_LDB(B0, 0, 0); PG8_LDB(B1, 0, 1); PG8_SCHED; PG8_LDA(At, 0, 0); PG8_STAGE(PG8_SA(1, 1), a1 + hstepA, voffA);
            PG8_WAIT_V(8); PG8_WAIT_L(0); PG8_BAR; PG8_MMA(0, 0, At, B0); PG8_MMA(0, 1, At, B1); PG8_BAR; PG8_SCHED;
            PG8_LDA(At, 0, 1); PG8_STAGE(PG8_SB(0, 0), b2, voffB); PG8_STAGE(PG8_SB(0, 1), b2 + hstepB, voffB); PG8_STAGE(PG8_SA(0, 0), a2, voffA);
            PG8_WAIT_V(8); PG8_WAIT_L(0); PG8_BAR; PG8_MMA(1, 0, At, B0); PG8_MMA(1, 1, At, B1); PG8_BAR; PG8_SCHED;
            PG8_LDB(B0, 1, 0); PG8_LDB(B1, 1, 1); PG8_SCHED; PG8_LDA(At, 1, 0); PG8_STAGE(PG8_SA(0, 1), a2 + hstepA, voffA);
            PG8_WAIT_V(8); PG8_WAIT_L(0); PG8_BAR; PG8_MMA(0, 0, At, B0); PG8_MMA(0, 1, At, B1); PG8_BAR; PG8_SCHED;
            PG8_LDA(At, 1, 1); PG8_STAGE(PG8_SB(1, 0), b3, voffB); PG8_STAGE(PG8_SB(1, 1), b3 + hstepB, voffB); PG8_STAGE(PG8_SA(1, 0), a3, voffA);
            PG8_WAIT_V(8); PG8_WAIT_L(0); PG8_BAR; PG8_MMA(1, 0, At, B0); PG8_MMA(1, 1, At, B1); PG8_BAR; PG8_SCHED;
            } else {
            PG8_LDB(B0, 0, 0); PG8_SCHED; PG8_LDA(At, 0, 0); PG8_STAGE(PG8_SA(1, 1), a1 + hstepA, voffA);
            PG8_WAIT_L(8); PG8_BAR; PG8_WAIT_L(0); PG8_MMA(0, 0, At, B0); PG8_BAR; PG8_SCHED;
            PG8_LDB(B1, 0, 1); PG8_STAGE(PG8_SB(0, 0), b2, voffB);
            PG8_BAR; PG8_WAIT_L(0); PG8_MMA(0, 1, At, B1); PG8_BAR;
            PG8_LDA(At, 0, 1); PG8_STAGE(PG8_SA(0, 0), a2, voffA);
            PG8_BAR; PG8_WAIT_L(0); PG8_MMA(1, 0, At, B0); PG8_BAR; PG8_SCHED;
            PG8_STAGE(PG8_SB(0, 1), b2 + hstepB, voffB);
            PG8_WAIT_V(6); PG8_BAR; PG8_MMA(1, 1, At, B1); PG8_BAR;
            PG8_LDB(B0, 1, 0); PG8_SCHED; PG8_LDA(At, 1, 0); PG8_STAGE(PG8_SA(0, 1), a2 + hstepA, voffA);
            PG8_WAIT_L(8); PG8_BAR; PG8_WAIT_L(0); PG8_MMA(0, 0, At, B0); PG8_BAR; PG8_SCHED;
            PG8_LDB(B1, 1, 1); PG8_STAGE(PG8_SB(1, 0), b3, voffB);
            PG8_BAR; PG8_WAIT_L(0); PG8_MMA(0, 1, At, B1); PG8_BAR;
            PG8_LDA(At, 1, 1); PG8_STAGE(PG8_SA(1, 0), a3, voffA);
            PG8_BAR; PG8_WAIT_L(0); PG8_MMA(1, 0, At, B0); PG8_BAR; PG8_SCHED;
            PG8_STAGE(PG8_SB(1, 1), b3 + hstepB, voffB);
            PG8_WAIT_V(6); PG8_BAR; PG8_MMA(1, 1, At, B1); PG8_BAR;
            }
        }
        if constexpr (ALIGN_EPI) { if (wr == 0) PG8_BAR; }
        if constexpr (!Epi::AFTER_DRAIN) { E(acc, cur, wr, wc, fr, fq); S.done(cur); }
        if (!has_next) break;
#pragma unroll
        for (int a = 0; a < 2; ++a)
#pragma unroll
            for (int b = 0; b < 2; ++b)
#pragma unroll
                for (int m = 0; m < 4; ++m)
#pragma unroll
                    for (int n = 0; n < 2; ++n) acc[a][b][m][n] = (f32x4){0.f, 0.f, 0.f, 0.f};
        cur = nxt; cA = nA; cB = nB; ++ui;
        if constexpr (ALIGN_EPI) { if (wr == 1) PG8_BAR; }
    }
    PG8_WAIT_V(0);
    if constexpr (!ALIGN_EPI) { if (wr == 0) PG8_BAR; }
    PG8_BAR;
    if constexpr (Epi::AFTER_DRAIN) { E.fused(acc, cur, wr, wc, fr, fq, lds, wid, lane); S.done(cur); }
#undef PG8_SA
#undef PG8_SB
#undef PG8_STAGE
#undef PG8_LDA
#undef PG8_LDB
#undef PG8_MMA
#undef PG8_WAIT_V
#undef PG8_WAIT_L
#undef PG8_BAR
#undef PG8_SCHED
}
}
#define LAS __attribute__((address_space(3)))
#define XB_TMO      128
#define XB_XCNT(j)  (256  + 64 * (j))
#define XB_XSUB(j)  (1280 + 64 * (j))
#define XB_XGEN(j)  (2304 + 64 * (j))
#define XB_TOP      3328
#define XB_TOPGEN   3392
#define XCD_BAR_WORDS 3456
#define XB_SPIN_CAP (1u << 18)

__device__ __forceinline__ unsigned xb_ld(unsigned* p)              { return __hip_atomic_load(p, __ATOMIC_RELAXED, __HIP_MEMORY_SCOPE_AGENT); }
__device__ __forceinline__ unsigned xb_add(unsigned* p, unsigned v) { return __hip_atomic_fetch_add(p, v, __ATOMIC_RELAXED, __HIP_MEMORY_SCOPE_AGENT); }
__device__ __forceinline__ unsigned xb_xcc_id() { return (unsigned)__builtin_amdgcn_s_getreg((3 << 11) | 20) & 0xFu; }
#define XB_SPIN(cond, bar) do { unsigned _sp = 0; while (cond) { __builtin_amdgcn_s_sleep(1); \
    if ((++_sp & 255u) == 0u) { if (xb_ld(&(bar)[XB_TMO])) break; if (_sp > XB_SPIN_CAP) { atomicAdd(&(bar)[XB_TMO], 1u); break; } } } } while (0)

struct XcdBarrier {
    unsigned* bar; unsigned x;
    volatile LAS unsigned* st;
};

__device__ __forceinline__ XcdBarrier xcd_barrier_post(unsigned* bar, volatile LAS unsigned* st) {
    XcdBarrier b; b.bar = bar; b.x = xb_xcc_id(); b.st = st;
    if (threadIdx.x == 0) (void)xb_add(&bar[XB_XCNT(b.x)], 1u);
    return b;
}
__device__ __forceinline__ void xcd_barrier_complete(unsigned* bar, unsigned x, unsigned& nloc, unsigned& nx) {
    const unsigned G = gridDim.x * gridDim.y * gridDim.z;
    unsigned sum, cnt, mine, sp = 0u;
    for (;;) {
        sum = 0u; cnt = 0u; mine = 0u;
#pragma unroll
        for (unsigned j = 0; j < 16; ++j) { const unsigned c = xb_ld(&bar[XB_XCNT(j)]); sum += c; cnt += (c > 0u) ? 1u : 0u; mine = (j == x) ? c : mine; }
        if (sum == G) break;
        __builtin_amdgcn_s_sleep(1);
        if ((++sp & 255u) == 0u) { if (xb_ld(&bar[XB_TMO])) break; if (sp > XB_SPIN_CAP) { atomicAdd(&bar[XB_TMO], 1u); break; } }
    }
    nloc = mine > 0u ? mine : 1u; nx = cnt > 0u ? cnt : 1u;
}

__device__ __forceinline__ void xcd_barrier(const XcdBarrier& b) {
    asm volatile("s_waitcnt vmcnt(0)" ::: "memory");
    __syncthreads();
    if (threadIdx.x == 0) {
        unsigned* bar = b.bar;
        __builtin_amdgcn_s_waitcnt(0);
        unsigned nloc = b.st[0], nx = b.st[1];
        if (nloc == 0u) { xcd_barrier_complete(bar, b.x, nloc, nx); b.st[0] = nloc; b.st[1] = nx; }
        const unsigned old = xb_add(&bar[XB_XSUB(b.x)], 1u);
        const unsigned gen = old / nloc;
        if (old + 1u == (gen + 1u) * nloc) {
            __builtin_amdgcn_fence(__ATOMIC_RELEASE, "agent");
            asm volatile("s_waitcnt vmcnt(0)" ::: "memory");
            const unsigned og = xb_add(&bar[XB_TOP], 1u);
            const unsigned tg = og / nx;
            if (og + 1u == (tg + 1u) * nx) xb_add(&bar[XB_TOPGEN], 1u);
            else XB_SPIN(xb_ld(&bar[XB_TOPGEN]) == tg, bar);
            __builtin_amdgcn_fence(__ATOMIC_ACQUIRE, "agent");
            xb_add(&bar[XB_XGEN(b.x)], 1u);
            asm volatile("s_waitcnt vmcnt(0)" ::: "memory");
        } else {
            XB_SPIN(xb_ld(&bar[XB_XGEN(b.x)]) == gen, bar);
            __builtin_amdgcn_fence(__ATOMIC_ACQUIRE, "agent");
            asm volatile("s_waitcnt vmcnt(0)" ::: "memory");
        }
    }
    __syncthreads();
}
constexpr int DM = 2048, NB = 2, SEQ = 16384, DEPTH = 4, CTXL = 256;
constexpr int NLAT = NB * SEQ, NCTX = NB * CTXL, MROWS = NLAT + NCTX;
constexpr int INW = 3584, Q_END = 1024, K_END = 1280, V_END = 1536, HY_END = 3072;
constexpr int HYW = 512, PLW = 512, MLPH = 8192, MODW = 6 * DM;
constexpr float EPS = 1e-6f;
constexpr int NIN = 28;
enum { I_X = 0, I_C, I_CTX, I_CCTX, I_WMOD, I_BMOD, I_GPREMIX, I_GPOSTMIX, I_GPREMLP, I_GPOSTMLP, I_WIN, I_WOUT, I_GBRANCH, I_SINK, I_HCW, I_HCB,
       I_HW1, I_HB1, I_HF1, I_HW2, I_HB2, I_HF2, I_HW3, I_HBIAS, I_POOLW, I_POOLS, I_WUP, I_WDOWN };

constexpr size_t MiB = 1u << 20;
constexpr size_t WS_CTL = 0, CTL_ZERO_BYTES = 1 * MiB;
constexpr size_t WS_MOD = 1 * MiB;
constexpr size_t WS_ROPE = 2 * MiB;
constexpr size_t WS_TW = 2 * MiB + 128 * 1024;
constexpr size_t WS_FPART = 3 * MiB;
constexpr size_t WS_XC = 6 * MiB;
constexpr size_t WS_MODP = 10 * MiB;
constexpr size_t WS_YA = 28 * MiB;
constexpr size_t WS_WT = 60 * MiB;
constexpr size_t WT_IN = 0, WT_OUT = 14 * MiB, WT_UP = 22 * MiB, WT_DOWN = 54 * MiB, WT_POOL = 86 * MiB, WT_LAYER = 86 * MiB + MiB / 2;
constexpr size_t WS_HX = 406 * MiB;
constexpr size_t WS_OX = 536 * MiB;
constexpr size_t WS_U = 666 * MiB;
constexpr size_t WS_H = WS_U;
constexpr size_t WS_PX = WS_U;
constexpr size_t WS_MERGED = WS_U + 228 * MiB;
constexpr size_t WS_POOLED = WS_U + 358 * MiB;
constexpr size_t WS_PORAW = WS_U + 391 * MiB;
constexpr size_t WS_VT = WS_U + 424 * MiB;
constexpr size_t WS_YT = WS_U + 457 * MiB;
constexpr size_t WS_HF = 1190 * MiB;
constexpr size_t WS_HFC = WS_HF + 64 * MiB;
constexpr size_t WS_SPEC = 1255 * MiB;
constexpr size_t WS_PART = WS_SPEC;
constexpr size_t WS_XB = 1384 * MiB;
constexpr size_t WS_END = 1514 * MiB;
static_assert(WS_WT + DEPTH * WT_LAYER <= WS_HX && WS_YT + (size_t)512 * MROWS * 4 <= WS_HF && WS_H + (size_t)MROWS * MLPH * 2 <= WS_HF, "d_ws map");

constexpr int LDS_RED = 139264;
constexpr int LDS_MISC = 140288;
constexpr int LDS_BYTES = 147456;

typedef unsigned short bf16;
typedef float f32x4 __attribute__((ext_vector_type(4)));
typedef float cf32 __attribute__((ext_vector_type(2)));
typedef short bf16x8 __attribute__((ext_vector_type(8)));
typedef short s16x4 __attribute__((ext_vector_type(4)));
typedef float f32x16 __attribute__((ext_vector_type(16)));
typedef unsigned u32x4 __attribute__((ext_vector_type(4)));
typedef unsigned u32x2 __attribute__((ext_vector_type(2)));
#define make_cf32(a, b) ((cf32){(a), (b)})

__device__ __forceinline__ unsigned f2bf(float f) { unsigned u = __builtin_bit_cast(unsigned, f); return (u + 0x7fffu + ((u >> 16) & 1u)) >> 16; }
__device__ __forceinline__ unsigned pk2(float lo, float hi) { return f2bf(lo) | (f2bf(hi) << 16); }
__device__ __forceinline__ float bf2f(unsigned short b) { return __builtin_bit_cast(float, (unsigned)b << 16); }
__device__ __forceinline__ float bflo(unsigned w) { return __builtin_bit_cast(float, w << 16); }
__device__ __forceinline__ float bfhi(unsigned w) { return __builtin_bit_cast(float, w & 0xffff0000u); }
__device__ __forceinline__ float wave_sum(float v) {
#pragma unroll
    for (int o = 1; o < 64; o <<= 1) v += __shfl_xor(v, o);
    return v;
}
struct Ctx {
    const float* in[NIN]; float* out; unsigned char* ws;
    LAS unsigned char* lds; char* ldsg;
    int tid, lane, wave, bid, G;
};
#define WSP(T, off) ((T*)(C.ws + (off)))

#define FFT_DEV __device__ __forceinline__
#define FFT_LDS LAS
#define FFT_SINCOSPI(x, s, c) do { *(s) = sinpif(x); *(c) = cospif(x); } while (0)
#define FFT_SYNC() __syncthreads()
__device__ __forceinline__ int fft_launder(int t) { asm volatile("" : "+v"(t)); return t; }
#define FFT_LAUNDER(t) fft_launder(t)
constexpr int FFT_N = 16384;
FFT_DEV int fpad(int i) { return i + (i >> 4); }
constexpr int FFT_SLOTS = FFT_N + (FFT_N >> 4);
FFT_DEV cf32 cadd(cf32 a, cf32 b) { return a + b; }
FFT_DEV cf32 csub(cf32 a, cf32 b) { return a - b; }
FFT_DEV cf32 cmul(cf32 a, cf32 b) { return a.xx * b + make_cf32(-a.y, a.y) * b.yx; }
FFT_DEV cf32 cmulc(cf32 a, cf32 b) { return b.xx * a + make_cf32(b.y, -b.y) * a.yx; }
template <bool INV> FFT_DEV void dft4(cf32& a, cf32& b, cf32& c, cf32& d) {
    const cf32 s0 = cadd(a, c), s1 = csub(a, c), s2 = cadd(b, d), s3 = csub(b, d);
    const cf32 t = INV ? make_cf32(-s3.y, s3.x) : make_cf32(s3.y, -s3.x);
    a = cadd(s0, s2); c = csub(s0, s2); b = cadd(s1, t); d = csub(s1, t);
}
template <bool INV> FFT_DEV void dft16(cf32 (&v)[16]) {
#pragma unroll
    for (int b = 0; b < 4; ++b) dft4<INV>(v[b], v[4 + b], v[8 + b], v[12 + b]);
    const float C1 = 0.92387953251128674f, S1 = 0.38268343236508977f, R2 = 0.70710678118654752f;
    const cf32 w1 = make_cf32(C1, INV ? S1 : -S1), w2 = make_cf32(R2, INV ? R2 : -R2), w3 = make_cf32(S1, INV ? C1 : -C1);
    const cf32 w6 = make_cf32(-R2, INV ? R2 : -R2), w9 = make_cf32(-C1, INV ? -S1 : S1);
    const cf32 w4 = make_cf32(0.f, INV ? 1.f : -1.f);
    v[4 * 1 + 1] = cmul(v[4 * 1 + 1], w1); v[4 * 1 + 2] = cmul(v[4 * 1 + 2], w2); v[4 * 1 + 3] = cmul(v[4 * 1 + 3], w3);
    v[4 * 2 + 1] = cmul(v[4 * 2 + 1], w2); v[4 * 2 + 2] = cmul(v[4 * 2 + 2], w4); v[4 * 2 + 3] = cmul(v[4 * 2 + 3], w6);
    v[4 * 3 + 1] = cmul(v[4 * 3 + 1], w3); v[4 * 3 + 2] = cmul(v[4 * 3 + 2], w6); v[4 * 3 + 3] = cmul(v[4 * 3 + 3], w9);
#pragma unroll
    for (int q1 = 0; q1 < 4; ++q1) dft4<INV>(v[4 * q1], v[4 * q1 + 1], v[4 * q1 + 2], v[4 * q1 + 3]);
}
constexpr int FFT_TW0 = 0, FFT_TW1 = 15 * 1024, FFT_TW2 = 15 * 1024 + 15 * 64, FFT_TWN = 15 * 1024 + 15 * 64 + 15 * 4;
template <int L> struct fft_twbase { static constexpr int v = L == 16384 ? FFT_TW0 : (L == 1024 ? FFT_TW1 : FFT_TW2); };
template <int L, bool INV> FFT_DEV void fft_pass16(FFT_LDS cf32* buf, int tid, const cf32* tw) {
    constexpr int S = L / 16;
#pragma unroll 1
    for (int k = 0; k < 2; ++k) {
        const int bf = tid + 512 * k, g = bf / S, j = bf % S, base = g * L + j;
        cf32 v[16], w[16];
        const cf32* twj = tw + fft_twbase<L>::v + j;
#pragma unroll
        for (int q = 1; q < 16; ++q) w[q] = twj[(q - 1) * S];
        if (!INV) {
#pragma unroll
            for (int m = 0; m < 16; ++m) v[m] = buf[fpad(base + m * S)];
            dft16<false>(v);
#pragma unroll
            for (int q = 1; q < 16; ++q) { const int p = 4 * (q & 3) + (q >> 2); v[p] = cmul(v[p], w[q]); }
#pragma unroll
            for (int q = 0; q < 16; ++q) buf[fpad(base + q * S)] = v[4 * (q & 3) + (q >> 2)];
        } else {
#pragma unroll
            for (int q = 0; q < 16; ++q) v[q] = buf[fpad(base + q * S)];
#pragma unroll
            for (int q = 1; q < 16; ++q) v[q] = cmulc(v[q], w[q]);
            dft16<true>(v);
#pragma unroll
            for (int m = 0; m < 16; ++m) buf[fpad(base + m * S)] = v[4 * (m & 3) + (m >> 2)];
        }
    }
}
template <bool INV> FFT_DEV void fft_pass4(FFT_LDS cf32* buf, int tid) {
#pragma unroll 1
    for (int k = 0; k < 8; ++k) {
        const int b0 = fpad(4 * (tid + 512 * k));
        cf32 a = buf[b0], b = buf[b0 + 1], c = buf[b0 + 2], d = buf[b0 + 3];
        dft4<INV>(a, b, c, d);
        buf[b0] = a; buf[b0 + 1] = b; buf[b0 + 2] = c; buf[b0 + 3] = d;
    }
}
#ifndef FFT_LAUNDER
#define FFT_LAUNDER(t) (t)
#endif
#define FFT_FORWARD(buf, tid, tw) do { fft_pass16<16384, false>(buf, FFT_LAUNDER(tid), tw); FFT_SYNC(); fft_pass16<1024, false>(buf, FFT_LAUNDER(tid), tw); FFT_SYNC(); \
    fft_pass16<64, false>(buf, FFT_LAUNDER(tid), tw); FFT_SYNC(); fft_pass4<false>(buf, FFT_LAUNDER(tid)); FFT_SYNC(); } while (0)
#define FFT_INVERSE(buf, tid, tw) do { fft_pass4<true>(buf, FFT_LAUNDER(tid)); FFT_SYNC(); fft_pass16<64, true>(buf, FFT_LAUNDER(tid), tw); FFT_SYNC(); \
    fft_pass16<1024, true>(buf, FFT_LAUNDER(tid), tw); FFT_SYNC(); fft_pass16<16384, true>(buf, FFT_LAUNDER(tid), tw); FFT_SYNC(); } while (0)
namespace att {
constexpr float SCALE = 0.088388347648318440f;
constexpr float THR = 8.f;
#define KSWZ(row, colB) ((row) * 256 + ((colB) ^ (((row) & 7) << 4)))
#define SBAR() __builtin_amdgcn_sched_barrier(0)
__device__ __forceinline__ int crow(int r, int hi) { return (r & 3) + 8 * (r >> 2) + 4 * hi; }
__device__ __forceinline__ unsigned cvtpk(float lo, float hi) {
  unsigned r; asm volatile("v_cvt_pk_bf16_f32 %0, %1, %2" : "=v"(r) : "v"(lo), "v"(hi)); return r;
}
__device__ __forceinline__ void partialSM(f32x16& p0, f32x16& p1, float& m_reg, float& mn, float& alpha) {
  constexpr float C = SCALE * 1.4426950408889634f;
  float pmax = p0[0]; for (int r = 1; r < 16; ++r) pmax = fmaxf(pmax, p0[r]); for (int r = 0; r < 16; ++r) pmax = fmaxf(pmax, p1[r]);
  { auto rr = __builtin_amdgcn_permlane32_swap(__float_as_uint(pmax), __float_as_uint(pmax), false, false);
    pmax = fmaxf(__uint_as_float(rr[0]), __uint_as_float(rr[1])); }
  if (__builtin_expect(__all(pmax - m_reg <= THR / SCALE), 1)) { mn = m_reg; alpha = 1.f; }
  else { mn = fmaxf(m_reg, pmax); alpha = __builtin_amdgcn_exp2f((m_reg - mn) * C); m_reg = mn; }
  float mnC = -mn * C;
  for (int r = 0; r < 16; ++r) p0[r] = fmaf(p0[r], C, mnC); for (int r = 0; r < 16; ++r) p1[r] = fmaf(p1[r], C, mnC);
  for (int r = 0; r < 16; ++r) p0[r] = __builtin_amdgcn_exp2f(p0[r]);
}
__device__ __forceinline__ void finishSM(f32x16& p0, f32x16& p1, float alpha, float& l_reg, bf16x8& pa0, bf16x8& pa1, bf16x8& pa2, bf16x8& pa3) {
  for (int r = 0; r < 16; ++r) p1[r] = __builtin_amdgcn_exp2f(p1[r]);
  float ps = 0; for (int r = 0; r < 16; ++r) ps += p0[r]; for (int r = 0; r < 16; ++r) ps += p1[r];
  { auto rr = __builtin_amdgcn_permlane32_swap(__float_as_uint(ps), __float_as_uint(ps), false, false);
    ps = __uint_as_float(rr[0]) + __uint_as_float(rr[1]); }
  l_reg = l_reg * alpha + ps;
#define PK4(P, BASE, OUT) do { unsigned a0 = cvtpk(P[BASE + 0], P[BASE + 1]), a1 = cvtpk(P[BASE + 2], P[BASE + 3]);   \
    unsigned b0 = cvtpk(P[BASE + 4], P[BASE + 5]), b1 = cvtpk(P[BASE + 6], P[BASE + 7]);                              \
    auto r0 = __builtin_amdgcn_permlane32_swap(a0, b0, false, false); auto r1 = __builtin_amdgcn_permlane32_swap(a1, b1, false, false); \
    u32x4 w = {r0[0], r1[0], r0[1], r1[1]}; OUT = *reinterpret_cast<bf16x8*>(&w); } while (0)
  PK4(p0, 0, pa0); PK4(p0, 8, pa1); PK4(p1, 0, pa2); PK4(p1, 8, pa3);
#undef PK4
}
__device__ __forceinline__ void qkt(f32x16& p0, f32x16& p1, const char* Ks, const bf16x8* qr, int r32, int hi) {
  p0 = f32x16{}; p1 = f32x16{};
  for (int d0 = 0; d0 < 8; ++d0) { int cb = (d0 * 16 + hi * 8) * 2;
    bf16x8 b0 = *reinterpret_cast<const bf16x8*>((const char*)Ks + KSWZ(r32, cb));
    bf16x8 b1 = *reinterpret_cast<const bf16x8*>((const char*)Ks + KSWZ(32 + r32, cb));
    p0 = __builtin_amdgcn_mfma_f32_32x32x16_bf16(b0, qr[d0], p0, 0, 0, 0);
    p1 = __builtin_amdgcn_mfma_f32_32x32x16_bf16(b1, qr[d0], p1, 0, 0, 0); }
}
__device__ __forceinline__ int v_st(int k, int c) { const int kk = (k & ~0xC) | ((k & 4) << 1) | ((k & 8) >> 1); return ((kk >> 3) * 4 + (c >> 5)) * 512 + ((kk & 7) * 32 + (c & 31)) * 2; }
__device__ __forceinline__ int v_rd_base(int lane) { return ((lane & 3) << 3) | (((lane >> 2) & 3) << 6) | (((lane >> 4) & 1) << 5) | (((lane >> 5) & 1) << 8); }
constexpr int v_rd_off(int d0, int ks, int half) { return d0 * 512 + ks * 4096 + half * 2048; }
template <int OFF> __device__ __forceinline__ s16x4 tr_read(int vb) {
  s16x4 r; asm volatile("ds_read_b64_tr_b16 %0, %1 offset:%2" : "=&v"(r) : "v"(vb), "i"(OFF) : "memory"); return r;
}
template <int D0> __device__ __forceinline__ void pv_one(f32x16& od, int vb, bf16x8 pa0, bf16x8 pa1, bf16x8 pa2, bf16x8 pa3) {
  const s16x4 l0 = tr_read<v_rd_off(D0, 0, 0)>(vb), h0 = tr_read<v_rd_off(D0, 0, 1)>(vb), l1 = tr_read<v_rd_off(D0, 1, 0)>(vb), h1 = tr_read<v_rd_off(D0, 1, 1)>(vb);
  const s16x4 l2 = tr_read<v_rd_off(D0, 2, 0)>(vb), h2 = tr_read<v_rd_off(D0, 2, 1)>(vb), l3 = tr_read<v_rd_off(D0, 3, 0)>(vb), h3 = tr_read<v_rd_off(D0, 3, 1)>(vb);
  asm volatile("s_waitcnt lgkmcnt(0)" ::: "memory"); SBAR();
#define PK(L, H) (bf16x8){L[0], L[1], L[2], L[3], H[0], H[1], H[2], H[3]}
  od = __builtin_amdgcn_mfma_f32_32x32x16_bf16(pa0, PK(l0, h0), od, 0, 0, 0);
  od = __builtin_amdgcn_mfma_f32_32x32x16_bf16(pa1, PK(l1, h1), od, 0, 0, 0);
  od = __builtin_amdgcn_mfma_f32_32x32x16_bf16(pa2, PK(l2, h2), od, 0, 0, 0);
  od = __builtin_amdgcn_mfma_f32_32x32x16_bf16(pa3, PK(l3, h3), od, 0, 0, 0);
#undef PK
}
__device__ __forceinline__ void pv_d0(f32x16* o, int vb, bf16x8 pa0, bf16x8 pa1, bf16x8 pa2, bf16x8 pa3) {
  pv_one<0>(o[0], vb, pa0, pa1, pa2, pa3); pv_one<1>(o[1], vb, pa0, pa1, pa2, pa3); pv_one<2>(o[2], vb, pa0, pa1, pa2, pa3); pv_one<3>(o[3], vb, pa0, pa1, pa2, pa3);
}

}
struct Args { const float* in[NIN]; float* out; unsigned char* ws; int ph_lo, ph_hi; };

#define PIN(i) (A.in[(i)])
#define WSA(T, off) ((T*)(A.ws + (off)))
#define LDS_WAIT() asm volatile("s_waitcnt lgkmcnt(0)" ::: "memory")

__device__ __forceinline__ float bfv(const u32x4& a, int i) { const unsigned w = a[i >> 1]; return (i & 1) ? bfhi(w) : bflo(w); }
__device__ __forceinline__ float silu_f(float x) { return x / (1.f + expf(-x)); }

__device__ __forceinline__ float block_sum(const Ctx& C, float v) {
    v = wave_sum(v); LAS float* red = (LAS float*)(C.lds + LDS_RED);
    __syncthreads(); if (C.lane == 0) red[C.wave] = v; __syncthreads();
    float s = 0.f;
#pragma unroll
    for (int w = 0; w < 8; ++w) s += red[w];
    return s;
}

__device__ __forceinline__ size_t tiled_off(int n, int k, int K) { return ((size_t)(n >> 8) * (K >> 6) + (k >> 6)) * 16384 + (size_t)((n & 255) * 64 + (k & 63)); }
__device__ __forceinline__ void transpose_item(const float* W, int K, int N, bf16* WT, LAS float* scr, int item, int lane) {
    const int nblk = N / 32, kb = item / nblk, nb = item % nblk, k0 = 64 * kb, n0 = 32 * nb;
#pragma unroll
    for (int i = 0; i < 8; ++i) { const int kk = 8 * i + (lane >> 3), nn = (lane & 7) * 4; const f32x4 v = *(const f32x4*)(W + (size_t)(k0 + kk) * N + n0 + nn);
        scr[kk * 33 + nn] = v.x; scr[kk * 33 + nn + 1] = v.y; scr[kk * 33 + nn + 2] = v.z; scr[kk * 33 + nn + 3] = v.w; }
    LDS_WAIT();
    const int c = lane & 7;
#pragma unroll
    for (int j = 0; j < 4; ++j) { const int n = (lane >> 3) + 8 * j; const LAS float* s = scr + (8 * c) * 33 + n;
        u32x4 o; o.x = pk2(s[0 * 33], s[1 * 33]); o.y = pk2(s[2 * 33], s[3 * 33]); o.z = pk2(s[4 * 33], s[5 * 33]); o.w = pk2(s[6 * 33], s[7 * 33]);
        *(u32x4*)(WT + tiled_off(n0 + n, k0 + 8 * c, K)) = o; }
    LDS_WAIT();
}
__device__ __forceinline__ void ph_pro_a(const Ctx& C, const Args& A) {
    LAS float* scr = (LAS float*)(C.lds + C.wave * 16384);
    const int gw = C.bid * 8 + C.wave, NGW = C.G * 8;
    constexpr int I_IN = (DM / 64) * (INW / 32), I_OUT = (DM / 64) * (DM / 32), I_UP = (DM / 64) * (MLPH / 32), I_DN = (MLPH / 64) * (DM / 32), I_L = I_IN + I_OUT + I_UP + I_DN;
    for (int it = gw; it < DEPTH * I_L; it += NGW) {
        const int l = it / I_L; int r = it % I_L; unsigned char* wl = A.ws + WS_WT + (size_t)l * WT_LAYER;
        if (r < I_IN) { transpose_item(PIN(I_WIN) + (size_t)l * DM * INW, DM, INW, (bf16*)(wl + WT_IN), scr, r, C.lane); continue; } r -= I_IN;
        if (r < I_OUT) { transpose_item(PIN(I_WOUT) + (size_t)l * DM * DM, DM, DM, (bf16*)(wl + WT_OUT), scr, r, C.lane); continue; } r -= I_OUT;
        if (r < I_UP) { transpose_item(PIN(I_WUP) + (size_t)l * DM * MLPH, DM, MLPH, (bf16*)(wl + WT_UP), scr, r, C.lane); continue; } r -= I_UP;
        transpose_item(PIN(I_WDOWN) + (size_t)l * MLPH * DM, MLPH, DM, (bf16*)(wl + WT_DOWN), scr, r, C.lane);
    }
    const int gt = C.bid * 512 + C.tid, NT = C.G * 512;
    for (int idx = gt; idx < DEPTH * 32768; idx += NT) {
        const int l = idx >> 15, rem = idx & 32767, nrow = rem >> 6, k8 = (rem & 63) * 8, g = nrow >> 7, d = nrow & 127, gk = k8 >> 7, c0 = k8 & 127;
        u32x4 o = (u32x4){0u, 0u, 0u, 0u};
        if (g == gk) { const float* w = PIN(I_POOLW) + ((size_t)(l * 4 + g) * 128 + c0) * 128 + d;
            o.x = pk2(w[0], w[128]); o.y = pk2(w[256], w[384]); o.z = pk2(w[512], w[640]); o.w = pk2(w[768], w[896]); }
        *(u32x4*)((bf16*)(A.ws + WS_WT + (size_t)l * WT_LAYER + WT_POOL) + tiled_off(nrow, k8, 512)) = o;
    }
    { const float* cin = PIN(I_C); const float* cctx = PIN(I_CCTX); const float* wmod = PIN(I_WMOD); float* modp = WSA(float, WS_MODP);
      for (int it = gw; it < DEPTH * 48 * 32; it += NGW) {
        const int l = it / 1536, rem = it % 1536, cg = rem >> 5, kc = rem & 31, col = cg * 256 + C.lane * 4, k = kc * 64 + C.lane;
        const float a0 = silu_f(cin[k]), a1 = silu_f(cin[DM + k]), a2 = silu_f(cctx[k]);
        f32x4 s0 = (f32x4){0.f, 0.f, 0.f, 0.f}, s1 = s0, s2 = s0; const float* wp = wmod + ((size_t)l * DM + kc * 64) * MODW + col;
#pragma unroll 8
        for (int kk = 0; kk < 64; ++kk) { const f32x4 w = *(const f32x4*)(wp + (size_t)kk * MODW);
            const float b0 = __shfl(a0, kk), b1 = __shfl(a1, kk), b2 = __shfl(a2, kk); s0 += w * b0; s1 += w * b1; s2 += w * b2; }
        float* o = modp + ((size_t)(l * 32 + kc) * 3) * MODW + col; *(f32x4*)o = s0; *(f32x4*)(o + MODW) = s1; *(f32x4*)(o + 2 * MODW) = s2;
      } }
    for (int idx = gt; idx < 256 * 32; idx += NT) { const int pos = idx >> 5, i = idx & 31; const float invf = powf(10000.0f, -(float)i / 32.0f), ang = (float)pos * invf;
        WSA(cf32, WS_ROPE)[idx] = make_cf32(cosf(ang), sinf(ang)); }
    for (int idx = gt; idx < FFT_TWN; idx += NT) { const int L = idx < FFT_TW1 ? 16384 : (idx < FFT_TW2 ? 1024 : 64), S = L / 16, r = idx - (idx < FFT_TW1 ? FFT_TW0 : (idx < FFT_TW2 ? FFT_TW1 : FFT_TW2));
        const int q = r / S + 1, j = r % S; const float x = -2.0f * (float)(j * q) / (float)L; WSA(cf32, WS_TW)[idx] = make_cf32(cospif(x), sinpif(x)); }
}
__device__ __forceinline__ void ph_pro_b(const Ctx& C, const Args& A) {
    const int gt = C.bid * 512 + C.tid, NT = C.G * 512; const float* modp = WSA(float, WS_MODP); float* mod = WSA(float, WS_MOD);
    for (int idx = gt; idx < DEPTH * 3 * MODW; idx += NT) { const int l = idx / (3 * MODW), rem = idx % (3 * MODW), s = rem / MODW, col = rem % MODW; float acc = PIN(I_BMOD)[l * MODW + col];
#pragma unroll 8
        for (int kc = 0; kc < 32; ++kc) acc += modp[((size_t)(l * 32 + kc) * 3 + s) * MODW + col];
        mod[idx] = acc; }
}

template <bool SRC_F32, bool DST_F32>
__device__ __forceinline__ void ph_rownorm(const Ctx& C, const Args& A, bool upd, const float* gpost, const float* gate,
                                           bool do_hx, const float* gpre, const float* shp, const float* scp, int nrows, int nslices) {
    const int gw = C.bid * 8 + C.wave, NGW = C.G * 8;
    const bf16* OX = WSA(bf16, WS_OX); bf16* HX = WSA(bf16, WS_HX); bf16* XB = WSA(bf16, WS_XB);
    const int c0 = 8 * C.lane;
#pragma unroll 1
    for (int s = 0; s < 3; ++s) {
        if (s == 2 && (gw & 3)) continue;
        const int rstep = s < 2 ? NGW : (NGW >> 2);
        const int rbeg = s < 2 ? s * SEQ + gw : NLAT + (gw >> 2), rend = s < 2 ? (s + 1) * SEQ : nrows;
        if (rbeg >= rend) continue;
        f32x4 gg[8], aa[8], sh[8];
#pragma unroll
        for (int m = 0; m < 8; ++m) { const int col = c0 + 512 * (m >> 1) + 4 * (m & 1);
            gg[m] = upd ? *(const f32x4*)(gpost + col) * *(const f32x4*)(gate + s * MODW + col) : (f32x4){0.f, 0.f, 0.f, 0.f};
            aa[m] = do_hx ? *(const f32x4*)(gpre + col) * (*(const f32x4*)(scp + s * MODW + col) + 1.f) : (f32x4){0.f, 0.f, 0.f, 0.f};
            sh[m] = do_hx ? *(const f32x4*)(shp + s * MODW + col) : (f32x4){0.f, 0.f, 0.f, 0.f}; }
#pragma unroll 1
        for (int r = rbeg; r < rend; r += rstep) {
            f32x4 xv[8];
            if (SRC_F32) { const float* xs = (s < 2 ? PIN(I_X) + (size_t)r * DM : PIN(I_CTX) + (size_t)(r - NLAT) * DM) + c0;
#pragma unroll
                for (int m = 0; m < 8; ++m) xv[m] = *(const f32x4*)(xs + 512 * (m >> 1) + 4 * (m & 1)); }
            else {
#pragma unroll
                for (int j = 0; j < 4; ++j) { const u32x4 w = *(const u32x4*)(XB + (size_t)r * DM + c0 + 512 * j);
                    xv[2 * j] = (f32x4){bflo(w.x), bfhi(w.x), bflo(w.y), bfhi(w.y)}; xv[2 * j + 1] = (f32x4){bflo(w.z), bfhi(w.z), bflo(w.w), bfhi(w.w)}; } }
            if (upd) {
                f32x4 ov[8]; float ss = 0.f;
                if (s < 2) {
#pragma unroll
                    for (int j = 0; j < 4; ++j) { const u32x4 w = *(const u32x4*)(OX + (size_t)r * DM + c0 + 512 * j);
                        ov[2 * j] = (f32x4){bflo(w.x), bfhi(w.x), bflo(w.y), bfhi(w.y)}; ov[2 * j + 1] = (f32x4){bflo(w.z), bfhi(w.z), bflo(w.w), bfhi(w.w)}; }
                } else {
                    const float* pp = WSA(float, WS_PART) + (size_t)(r - NLAT) * DM + c0;
#pragma unroll
                    for (int m = 0; m < 8; ++m) ov[m] = (f32x4){0.f, 0.f, 0.f, 0.f};
#pragma unroll 1
                    for (int ks = 0; ks < nslices; ++ks) {
#pragma unroll
                        for (int m = 0; m < 8; ++m) ov[m] += *(const f32x4*)(pp + (size_t)ks * NCTX * DM + 512 * (m >> 1) + 4 * (m & 1)); }
                }
#pragma unroll
                for (int m = 0; m < 8; ++m) ss += (ov[m].x * ov[m].x + ov[m].y * ov[m].y) + (ov[m].z * ov[m].z + ov[m].w * ov[m].w);
                const float rstd = rsqrtf(wave_sum(ss) * (1.f / DM) + EPS);
#pragma unroll
                for (int m = 0; m < 8; ++m) xv[m] += gg[m] * (ov[m] * rstd);
                if (DST_F32) {
#pragma unroll
                    for (int m = 0; m < 8; ++m) *(f32x4*)(A.out + (size_t)r * DM + c0 + 512 * (m >> 1) + 4 * (m & 1)) = xv[m]; }
                else {
#pragma unroll
                    for (int j = 0; j < 4; ++j) { u32x4 w; w.x = pk2(xv[2 * j].x, xv[2 * j].y); w.y = pk2(xv[2 * j].z, xv[2 * j].w); w.z = pk2(xv[2 * j + 1].x, xv[2 * j + 1].y); w.w = pk2(xv[2 * j + 1].z, xv[2 * j + 1].w);
                        *(u32x4*)(XB + (size_t)r * DM + c0 + 512 * j) = w;
                        xv[2 * j] = (f32x4){bflo(w.x), bfhi(w.x), bflo(w.y), bfhi(w.y)}; xv[2 * j + 1] = (f32x4){bflo(w.z), bfhi(w.z), bflo(w.w), bfhi(w.w)}; } }
            }
            if (do_hx) {
                float ss = 0.f;
#pragma unroll
                for (int m = 0; m < 8; ++m) ss += (xv[m].x * xv[m].x + xv[m].y * xv[m].y) + (xv[m].z * xv[m].z + xv[m].w * xv[m].w);
                const float rstd = rsqrtf(wave_sum(ss) * (1.f / DM) + EPS);
#pragma unroll
                for (int j = 0; j < 4; ++j) { const f32x4 h0 = (xv[2 * j] * rstd) * aa[2 * j] + sh[2 * j], h1 = (xv[2 * j + 1] * rstd) * aa[2 * j + 1] + sh[2 * j + 1];
                    u32x4 w; w.x = pk2(h0.x, h0.y); w.y = pk2(h0.z, h0.w); w.z = pk2(h1.x, h1.y); w.w = pk2(h1.z, h1.w);
                    *(u32x4*)(HX + (size_t)r * DM + c0 + 512 * j) = w; }
            }
        }
    }
}

template <int CTRL, int ROWMASK> __device__ __forceinline__ float dpp_add(float x) {
    return x + __builtin_bit_cast(float, __builtin_amdgcn_update_dpp(0, __builtin_bit_cast(int, x), CTRL, ROWMASK, 0xF, false));
}
__device__ __forceinline__ void ph_filter_mlp(const Ctx& C, const Args& A, int l) {
    LAS float* feats = (LAS float*)C.lds;
    LAS float* h1 = feats + 65 * 36;
    LAS unsigned short* h2h = (LAS unsigned short*)(h1 + 65 * 64);
    LAS unsigned short* h2l = h2h + 72 * 72;
    const float* w1 = PIN(I_HW1) + l * 33 * 64; const float* b1 = PIN(I_HB1) + l * 64; const float* f1 = PIN(I_HF1) + l * 64;
    const float* w2 = PIN(I_HW2) + l * 64 * 64; const float* b2 = PIN(I_HB2) + l * 64; const float* f2 = PIN(I_HF2) + l * 64;
    const float* w3 = PIN(I_HW3) + (size_t)l * 64 * 1024; float* fpart = WSA(float, WS_FPART); float* HF = WSA(float, WS_HF); float* HFC = WSA(float, WS_HFC);
    for (int it = C.bid; it < 256; it += C.G) {
        const int i0 = it * 64;
#pragma unroll 1
        for (int idx = C.tid; idx < 65 * 33; idx += 512) { const int p = idx / 33, f = idx % 33, n = p < 64 ? SEQ : CTXL, i = p < 64 ? i0 + p : it; float val;
            if (f == 0) val = (float)i / (float)(n - 1);
            else { const int j = (f - 1) & 15; const float fj = 1e-4f + (float)j * ((15.0f - 1e-4f) / 15.0f), om = (6.283185307179586f * (float)i) / (float)n, a = fj * om;
                val = (f <= 16) ? cosf(a) : -sinf(a); }
            feats[p * 36 + f] = val; }
        __syncthreads();
        { const int u = fft_launder(C.tid & 63); float wc[33];
#pragma unroll
          for (int f = 0; f < 33; ++f) wc[f] = w1[f * 64 + u];
          float wc2[64];
#pragma unroll
          for (int k = 0; k < 64; ++k) wc2[k] = w2[k * 64 + u];
          { const float bu = b1[u], fu = f1[u];
#pragma unroll 1
          for (int p = C.tid >> 6; p < 65; p += 8) { float acc = bu;
#pragma unroll
              for (int f = 0; f < 33; ++f) acc += feats[p * 36 + f] * wc[f];
              h1[p * 64 + u] = sinf(fu * acc); } }
        __syncthreads();
          const float bu = b2[u], fu = f2[u];
#pragma unroll 1
          for (int p = C.tid >> 6; p < 65; p += 8) { float acc = bu;
#pragma unroll
              for (int k4 = 0; k4 < 16; ++k4) { const f32x4 hv = *(const LAS f32x4*)(h1 + p * 64 + 4 * k4);
                  acc += hv.x * wc2[4 * k4] + hv.y * wc2[4 * k4 + 1] + hv.z * wc2[4 * k4 + 2] + hv.w * wc2[4 * k4 + 3]; }
              const float v = sinf(fu * acc); const unsigned vb = __builtin_bit_cast(unsigned, v) & 0xffff0000u;
              h2h[p * 72 + u] = (unsigned short)(vb >> 16); h2l[p * 72 + u] = (unsigned short)(__builtin_bit_cast(unsigned, v - __builtin_bit_cast(float, vb)) >> 16); } }
        __syncthreads();
        {
          const int r32 = C.lane & 31, hi = C.lane >> 5, ob = fft_launder(C.wave * 128);
          const float d0 = 3.0701134573253945f * 1.4426950408889634f, d1 = (12.280453829301578f / 511.0f) * 1.4426950408889634f;
#pragma unroll 1
          for (int mb = 0; mb < 4; ++mb) {
              bf16x8 Ah[4], Al[4];
              const unsigned widx = (unsigned)(hi * 8 * 1024 + ob + mb * 32 + r32);
#pragma unroll
              for (int kk = 0; kk < 4; ++kk) { u32x4 hw, lw;
#pragma unroll
                  for (int jj = 0; jj < 4; ++jj) { const float w0 = (w3 + (kk * 16 + 2 * jj) * 1024)[widx], w1 = (w3 + (kk * 16 + 2 * jj + 1) * 1024)[widx];
                      const unsigned u0 = __builtin_bit_cast(unsigned, w0) & 0xffff0000u, u1 = __builtin_bit_cast(unsigned, w1) & 0xffff0000u;
                      hw[jj] = (u0 >> 16) | u1;
                      lw[jj] = (__builtin_bit_cast(unsigned, w0 - __builtin_bit_cast(float, u0)) >> 16) | (__builtin_bit_cast(unsigned, w1 - __builtin_bit_cast(float, u1)) & 0xffff0000u); }
                  Ah[kk] = __builtin_bit_cast(bf16x8, hw); Al[kk] = __builtin_bit_cast(bf16x8, lw); }
              float s[16];
#pragma unroll
              for (int r = 0; r < 16; ++r) s[r] = 0.f;
              const int cb = ((ob + mb * 32) & 511) + 4 * hi;
#pragma unroll 1
              for (int nb = 0; nb < 3; ++nb) {
                  const int prow = nb < 2 ? nb * 32 + r32 : 64;
                  f32x16 acc = {};
#pragma unroll
                  for (int kk = 0; kk < 4; ++kk) { const bf16x8 bh = *(const LAS bf16x8*)(h2h + prow * 72 + kk * 16 + hi * 8), bl = *(const LAS bf16x8*)(h2l + prow * 72 + kk * 16 + hi * 8);
                      acc = __builtin_amdgcn_mfma_f32_32x32x16_bf16(Ah[kk], bh, acc, 0, 0, 0);
                      acc = __builtin_amdgcn_mfma_f32_32x32x16_bf16(Ah[kk], bl, acc, 0, 0, 0);
                      acc = __builtin_amdgcn_mfma_f32_32x32x16_bf16(Al[kk], bh, acc, 0, 0, 0); }
                  const float t = nb < 2 ? (float)(i0 + prow) / (float)(SEQ - 1) : (float)it / (float)(CTXL - 1);
                  const float a = -t * d1, b = -t * d0 + a * (float)cb;
                  float elo[4], ehi[4];
#pragma unroll
                  for (int j = 0; j < 4; ++j) { elo[j] = __builtin_amdgcn_exp2f(b + a * (float)j); ehi[j] = __builtin_amdgcn_exp2f(a * (float)(8 * j)); }
                  float v[16];
#pragma unroll
                  for (int r = 0; r < 16; ++r) v[r] = acc[r] * (elo[r & 3] * ehi[r >> 2]);
                  if (nb < 2) { const unsigned hidx = (unsigned)((ob + mb * 32 + 4 * hi) * SEQ + i0 + prow);
#pragma unroll
                      for (int r = 0; r < 16; ++r) { (HF + (size_t)att::crow(r, 0) * SEQ)[hidx] = v[r]; s[r] += fabsf(v[r]); } }
                  else if (r32 == 0) {
#pragma unroll
                      for (int r = 0; r < 16; ++r) { const int o = ob + mb * 32 + att::crow(r, hi); HFC[(size_t)o * CTXL + it] = v[r]; fpart[(256 + it) * 1024 + o] = fabsf(v[r]); } }
              }
#pragma unroll
              for (int r = 0; r < 16; ++r) { float x = s[r];
                  x = dpp_add<0xB1, 0xF>(x); x = dpp_add<0x4E, 0xF>(x); x = dpp_add<0x141, 0xF>(x); x = dpp_add<0x140, 0xF>(x); x = dpp_add<0x142, 0xA>(x);
                  if (r32 == 16) fpart[it * 1024 + ob + mb * 32 + att::crow(r, hi)] = x; }
          } }
        __syncthreads();
    }
}
__device__ __forceinline__ int fft_freq_of(int p) { return (p >> 10) + 16 * ((p >> 6) & 15) + 256 * ((p >> 2) & 15) + 4096 * (p & 3); }
__device__ __forceinline__ int fft_pos_of(int f) { return 1024 * (f & 15) + 64 * ((f >> 4) & 15) + 4 * ((f >> 8) & 15) + (f >> 12); }
__device__ __forceinline__ void ph_filter_fft(const Ctx& C, const Args& A, int extra, int d) {
    LAS cf32* buf = (LAS cf32*)C.lds; const float* HF = WSA(float, WS_HF); const float* FP = WSA(float, WS_FPART); cf32* SPEC = WSA(cf32, WS_SPEC); const cf32* tw = WSA(cf32, WS_TW);
    const cf32 wstep = make_cf32(cospif(-1.0f / SEQ), sinpif(-1.0f / SEQ));
    constexpr int NIT = 512;
    const int nlow = C.G - extra, nA = (nlow * d < NIT) ? nlow * d : 0, dA = nA ? d : 0;
    const int myA = (C.bid >= extra) ? dA : 0, nB = NIT - nA, myB = (nB - C.bid + C.G - 1) / C.G > 0 ? (nB - C.bid + C.G - 1) / C.G : 0;
#pragma unroll 1
    for (int k = 0; k < myA + myB; ++k) {
        const int it = k < myA ? (C.bid - extra) + nlow * k : nA + C.bid + C.G * (k - myA);
        const int c0 = it >> 1, c1 = c0 + 256, e = it & 1;
        const float part0 = C.tid < 256 ? FP[C.tid * 1024 + c0] + FP[C.tid * 1024 + 512 + c0] : 0.f, part1 = C.tid < 256 ? FP[C.tid * 1024 + c1] + FP[C.tid * 1024 + 512 + c1] : 0.f;
        const float inv0 = 1.f / block_sum(C, part0), inv1 = 1.f / block_sum(C, part1);
        const float* hf0 = HF + (size_t)c0 * SEQ; const float* hb0 = HF + (size_t)(512 + c0) * SEQ; const float* hf1 = HF + (size_t)c1 * SEQ; const float* hb1 = HF + (size_t)(512 + c1) * SEQ;
#pragma unroll 2
        for (int q = 0; q < 8; ++q) { const int t0 = (C.tid + 512 * q) * 4; const f32x4 a0 = *(const f32x4*)(hf0 + t0), a1 = *(const f32x4*)(hf1 + t0);
            cf32 w = make_cf32(1.f, 0.f); if (e) { const float x = -(float)t0 * (1.0f / SEQ); w = make_cf32(cospif(x), sinpif(x)); }
#pragma unroll
            for (int i = 0; i < 4; ++i) { const int t = t0 + i, tb = (t == 0) ? 0 : SEQ - t; const float b0 = hb0[tb], b1 = hb1[tb]; cf32 v;
                if (e == 0 || t == 0) v = make_cf32((a0[i] + b0) * inv0, (a1[i] + b1) * inv1); else v = cmul(make_cf32((a0[i] - b0) * inv0, (a1[i] - b1) * inv1), w);
                buf[fpad(t)] = v; if (e) w = cmul(w, wstep); } }
        __syncthreads();
        FFT_FORWARD(buf, C.tid, tw);
        cf32* sp0 = SPEC + (size_t)(c0 * 2 + e) * SEQ; cf32* sp1 = SPEC + (size_t)(c1 * 2 + e) * SEQ;
#pragma unroll 2
        for (int q = 0; q < 16; ++q) { const int p0 = (C.tid + 512 * q) * 2; f32x4 o0, o1;
#pragma unroll
            for (int i = 0; i < 2; ++i) { const int p = p0 + i, f = fft_freq_of(p), fm = e ? (SEQ - 1 - f) : ((SEQ - f) & (SEQ - 1)), pm = fft_pos_of(fm);
                const cf32 zf = buf[fpad(p)], zm = buf[fpad(pm)], zc = make_cf32(zm.x, -zm.y), ka = (zf + zc) * 0.5f, dd = (zf - zc) * 0.5f;
                o0[2 * i] = ka.x; o0[2 * i + 1] = ka.y; o1[2 * i] = dd.y; o1[2 * i + 1] = -dd.x; }
            *(f32x4*)(sp0 + p0) = o0; *(f32x4*)(sp1 + p0) = o1; }
        __syncthreads();
    }
}
template <int E, int VAR = 0> __device__ __forceinline__ void conv_half(const Ctx& C, LAS cf32* buf, const bf16* v0, const bf16* v1, const cf32* sp, const cf32* tw, cf32 (&ya)[32], float* y0, float* y1) {
    const int tidl = fft_launder(C.tid);
    const cf32 wstep = make_cf32(cospif(-1.0f / SEQ), sinpif(-1.0f / SEQ));
#pragma unroll 1
    for (int k = 0; k < 4; ++k) { const int t0 = (tidl + 512 * k) * 8; const u32x4 a = *(const u32x4*)(v0 + t0), b = *(const u32x4*)(v1 + t0);
        cf32 w = make_cf32(1.f, 0.f); if (E) { const float x = -(float)t0 * (1.0f / SEQ); w = make_cf32(cospif(x), sinpif(x)); }
#pragma unroll
        for (int i = 0; i < 8; ++i) { cf32 z = make_cf32(bfv(a, i), bfv(b, i)); if (E) { z = cmul(z, w); w = cmul(w, wstep); } buf[fpad(t0 + i)] = z; } }
    __syncthreads();
    if (VAR != 1) { fft_pass16<16384, false>(buf, FFT_LAUNDER(tidl), tw); FFT_SYNC(); fft_pass16<1024, false>(buf, FFT_LAUNDER(tidl), tw); FFT_SYNC(); fft_pass16<64, false>(buf, FFT_LAUNDER(tidl), tw); FFT_SYNC(); }
#pragma unroll 2
    for (int k = 0; k < 8; ++k) { const int p0 = (tidl + 512 * k) * 4, b0 = fpad(p0); const f32x4 s0 = *(const f32x4*)(sp + p0), s1 = *(const f32x4*)(sp + p0 + 2);
        cf32 a = buf[b0], b = buf[b0 + 1], c = buf[b0 + 2], d = buf[b0 + 3];
        dft4<false>(a, b, c, d);
        a = cmul(a, make_cf32(s0.x, s0.y)); b = cmul(b, make_cf32(s0.z, s0.w)); c = cmul(c, make_cf32(s1.x, s1.y)); d = cmul(d, make_cf32(s1.z, s1.w));
        dft4<true>(a, b, c, d);
        buf[b0] = a; buf[b0 + 1] = b; buf[b0 + 2] = c; buf[b0 + 3] = d; }
    FFT_SYNC();
    if (VAR != 1) { fft_pass16<64, true>(buf, FFT_LAUNDER(tidl), tw); FFT_SYNC(); fft_pass16<1024, true>(buf, FFT_LAUNDER(tidl), tw); FFT_SYNC(); fft_pass16<16384, true>(buf, FFT_LAUNDER(tidl), tw); FFT_SYNC(); }
    if (E == 0) {
#pragma unroll
        for (int k = 0; k < 8; ++k) { const int t0 = (tidl + 512 * k) * 4;
#pragma unroll
            for (int i = 0; i < 4; ++i) ya[4 * k + i] = buf[fpad(t0 + i)]; } }
    else {
        const cf32 wstepc = make_cf32(wstep.x, -wstep.y);
#pragma unroll
        for (int k = 0; k < 8; ++k) { const int t0 = (tidl + 512 * k) * 4; const float x = (float)t0 * (1.0f / SEQ); cf32 w = make_cf32(cospif(x), sinpif(x));
            f32x4 o0, o1; const float sc = 1.0f / (2 * SEQ);
#pragma unroll
            for (int i = 0; i < 4; ++i) { const cf32 yb = cmul(buf[fpad(t0 + i)], w); w = cmul(w, wstepc); o0[i] = (ya[4 * k + i].x + yb.x) * sc; o1[i] = (ya[4 * k + i].y + yb.y) * sc; }
            *(f32x4*)(y0 + t0) = o0; *(f32x4*)(y1 + t0) = o1; asm volatile("" ::: "memory"); } }
    __syncthreads();
}
template <int VAR = 0> __device__ __forceinline__ void ph_conv(const Ctx& C, const Args& A) {
    LAS cf32* buf = (LAS cf32*)C.lds; const bf16* VT = WSA(bf16, WS_VT); float* YT = WSA(float, WS_YT); const cf32* SPEC = WSA(cf32, WS_SPEC); const cf32* tw = WSA(cf32, WS_TW);
#pragma unroll 1
    for (int c = C.bid; c < HYW; c += C.G) {
        const bf16* v0 = VT + (size_t)c * MROWS; const bf16* v1 = v0 + SEQ; float* y0 = YT + (size_t)c * MROWS; cf32 ya[32];
        conv_half<0, VAR>(C, buf, v0, v1, SPEC + (size_t)(c * 2) * SEQ, tw, ya, y0, y0 + SEQ);
        conv_half<1, VAR>(C, buf, v0, v1, SPEC + (size_t)(c * 2 + 1) * SEQ, tw, ya, y0, y0 + SEQ);
    }
}
__device__ __forceinline__ void ph_conv_ctx(const Ctx& C, const Args& A) {
    LAS float* taps = (LAS float*)C.lds; LAS float* vb = taps + 512;
    const float* HFC = WSA(float, WS_HFC); const float* FP = WSA(float, WS_FPART); const bf16* VT = WSA(bf16, WS_VT); float* YT = WSA(float, WS_YT);
    for (int c = C.bid; c < HYW; c += C.G) {
        const float part = C.tid < 256 ? FP[(256 + C.tid) * 1024 + c] + FP[(256 + C.tid) * 1024 + 512 + c] : 0.f;
        const float inv = 1.f / block_sum(C, part);
        if (C.tid < 511) { const int d = C.tid - 255; const float k = d > 0 ? HFC[(size_t)c * CTXL + d] : (d < 0 ? HFC[(size_t)(512 + c) * CTXL - d] : HFC[(size_t)c * CTXL] + HFC[(size_t)(512 + c) * CTXL]);
            taps[C.tid] = k * inv; }
        vb[C.tid] = bf2f(VT[(size_t)c * MROWS + NLAT + C.tid]);
        __syncthreads();
        const int b = C.tid >> 8, t = C.tid & 255; float acc = 0.f;
#pragma unroll 8
        for (int s = 0; s < CTXL; ++s) acc += taps[t - s + 255] * vb[b * CTXL + s];
        YT[(size_t)c * MROWS + NLAT + C.tid] = acc;
        __syncthreads();
    }
}

__device__ __forceinline__ void seq_of_row(int r, int& seq0, int& seqlen) { if (r < NLAT) { seq0 = r & ~(SEQ - 1); seqlen = SEQ; } else { seq0 = NLAT + ((r - NLAT) & ~(CTXL - 1)); seqlen = CTXL; } }
__device__ __forceinline__ void ph_krope(const Ctx& C, const Args& A) {
    const int gt = C.bid * 512 + C.tid, NT = C.G * 512; bf16* PX = WSA(bf16, WS_PX); const cf32* ROPE = WSA(cf32, WS_ROPE);
    for (int idx = gt; idx < NLAT * 16; idx += NT) { const int r = idx >> 4, sub = idx & 15, kvh = sub >> 3, half = (sub >> 2) & 1, q = sub & 3, t = r & (SEQ - 1), pos = half ? (t & 63) : (t >> 6);
        bf16* p = PX + (size_t)r * INW + Q_END + kvh * 128 + half * 64 + q * 8; const u32x4 a = *(const u32x4*)p, b = *(const u32x4*)(p + 32); const cf32* rt = ROPE + pos * 32 + q * 8;
        float n1[8], n2[8];
#pragma unroll
        for (int i = 0; i < 8; ++i) { const float x1 = bfv(a, i), x2 = bfv(b, i); const cf32 cs = rt[i]; n1[i] = x1 * cs.x - x2 * cs.y; n2[i] = x2 * cs.x + x1 * cs.y; }
        u32x4 oa, ob; oa.x = pk2(n1[0], n1[1]); oa.y = pk2(n1[2], n1[3]); oa.z = pk2(n1[4], n1[5]); oa.w = pk2(n1[6], n1[7]);
        ob.x = pk2(n2[0], n2[1]); ob.y = pk2(n2[2], n2[3]); ob.z = pk2(n2[4], n2[5]); ob.w = pk2(n2[6], n2[7]);
        *(u32x4*)p = oa; *(u32x4*)(p + 32) = ob; }
}
__device__ __forceinline__ void ph_hyena_pre(const Ctx& C, const Args& A, int l, int nrows) {
    LAS unsigned short* tile = (LAS unsigned short*)C.lds;
    const bf16* PX = WSA(bf16, WS_PX); bf16* VT = WSA(bf16, WS_VT);
    const float* cw = PIN(I_HCW) + l * 3 * 1536; const float* cb = PIN(I_HCB) + l * 1536;
    const int ct = C.bid & 7, c8 = (C.tid & 7) * 8, ch = ct * 64 + c8, tt = C.tid >> 3;
    float wx[3][8], wv[3][8], bx[8], bv[8];
#pragma unroll
    for (int i = 0; i < 8; ++i) { bx[i] = cb[512 + ch + i]; bv[i] = cb[1024 + ch + i];
#pragma unroll
        for (int d = 0; d < 3; ++d) { wx[d][i] = cw[d * 1536 + 512 + ch + i]; wv[d][i] = cw[d * 1536 + 1024 + ch + i]; } }
    u32x4 ra[3], rb[3], na[3], nb[3];
#define HP_LOAD(TL, DA, DB) do { const int r0_ = (TL) * 64; int s0_, sl_; seq_of_row(r0_, s0_, sl_); const int r_ = r0_ + tt, tin_ = r_ - s0_; \
        _Pragma("unroll") for (int d = 0; d < 3; ++d) { const bool ok_ = (tin_ + d - 1 >= 0) && (tin_ + d - 1 < sl_); const bf16* p_ = PX + (size_t)(r_ + d - 1) * INW + V_END + ch; \
            DA[d] = ok_ ? *(const u32x4*)(p_ + 512) : (u32x4){0u, 0u, 0u, 0u}; DB[d] = ok_ ? *(const u32x4*)(p_ + 1024) : (u32x4){0u, 0u, 0u, 0u}; } } while (0)
    int tl = C.bid >> 3; const int tstep = C.G >> 3;
    const int ntl = nrows / 64;
    if (tl < ntl) HP_LOAD(tl, ra, rb);
#pragma unroll 1
    for (; tl < ntl; tl += tstep) {
        const int r0 = tl * 64;
        if (tl + tstep < ntl) HP_LOAD(tl + tstep, na, nb);
        float x1[8], vv[8];
#pragma unroll
        for (int i = 0; i < 8; ++i) { x1[i] = bx[i]; vv[i] = bv[i]; }
#pragma unroll
        for (int d = 0; d < 3; ++d) {
#pragma unroll
            for (int i = 0; i < 8; ++i) { x1[i] += bfv(ra[d], i) * wx[d][i]; vv[i] += bfv(rb[d], i) * wv[d][i]; } }
#pragma unroll
        for (int i = 0; i < 8; ++i) tile[(c8 + i) * 72 + tt] = (unsigned short)f2bf(x1[i] * vv[i]);
        __syncthreads();
        const int cc = C.tid >> 3, t8 = (C.tid & 7) * 8;
        const u32x4 o = *(const LAS u32x4*)(tile + cc * 72 + t8);
        *(u32x4*)(VT + (size_t)(ct * 64 + cc) * MROWS + r0 + t8) = o;
        __syncthreads();
#pragma unroll
        for (int d = 0; d < 3; ++d) { ra[d] = na[d]; rb[d] = nb[d]; }
    }
#undef HP_LOAD
}
__device__ __forceinline__ void ph_pool_pre(const Ctx& C, const Args& A, int nrows) {
    LAS u32x4* st = (LAS u32x4*)C.lds;
    const bf16* PX = WSA(bf16, WS_PX); bf16* PO = WSA(bf16, WS_POOLED);
    for (int tl = C.bid; tl < nrows / 64; tl += C.G) {
        const int r0 = tl * 64; int seq0, seqlen; seq_of_row(r0, seq0, seqlen); const int tin0 = r0 - seq0;
#pragma unroll
        for (int k = 0; k < 10; ++k) { const int idx = C.tid + 512 * k, rr = idx >> 6, ck = idx & 63, tin = tin0 - 8 + rr;
            st[idx] = (tin >= 0 && tin < seqlen) ? *(const u32x4*)(PX + (size_t)(seq0 + tin) * INW + HY_END + ck * 8) : (u32x4){0u, 0u, 0u, 0u}; }
        __syncthreads();
#pragma unroll 1
        for (int k = 0; k < 8; ++k) { const int idx = C.tid + 512 * k, tt = idx >> 6, ck = idx & 63, g = ck >> 4, h = 1 << g, tin = tin0 + tt;
            float s[8];
#pragma unroll
            for (int i = 0; i < 8; ++i) s[i] = 0.f;
            for (int q = tt + 8 - h; q < tt + 8 + h; ++q) { const u32x4 a = st[q * 64 + ck];
#pragma unroll
                for (int i = 0; i < 8; ++i) s[i] += bfv(a, i); }
            const u32x4 xs = st[(tt + 8) * 64 + ck]; const int lo = tin - h > 0 ? tin - h : 0, hi = tin + h < seqlen ? tin + h : seqlen; const float invc = 1.f / (float)(hi - lo); float o[8];
#pragma unroll
            for (int i = 0; i < 8; ++i) o[i] = s[i] * invc - bfv(xs, i);
            u32x4 w; w.x = pk2(o[0], o[1]); w.y = pk2(o[2], o[3]); w.z = pk2(o[4], o[5]); w.w = pk2(o[6], o[7]);
            *(u32x4*)(PO + (size_t)(r0 + tt) * 512 + ck * 8) = w; }
        __syncthreads();
    }
}
__device__ __forceinline__ void ph_attention(const Ctx& C, const Args& A, int l, bool do_ctx) {
    using namespace att;
    const bf16* PX = WSA(bf16, WS_PX); bf16* MG = WSA(bf16, WS_MERGED); const cf32* ROPE = WSA(cf32, WS_ROPE);
    char* LB = C.ldsg; float* wsf = (float*)(C.ldsg + 131072) + C.wave * 64; float* li_l = wsf; float* al_l = wsf + 32;
    const int tid = C.tid, lane = C.lane, wid = C.wave, r32 = lane & 31, hi = lane >> 5;
    const int sr = tid >> 4, sc = (tid & 15) * 8, vst0 = v_st(sr, sc), vst1 = v_st(32 + sr, sc);
    const int vbase = (int)(uintptr_t)LB + v_rd_base(lane);
    unsigned doff[8];
#pragma unroll
    for (int q = 0; q < 8; ++q) { const int pc = wid + 8 * q, region = pc >> 4, ob = (pc & 15) * 1024 + lane * 16;
        int key, col;
        if (region >= 2) { const int row = ob >> 8; key = (region & 1) * 64 + row; col = ((ob & 255) ^ ((row & 7) << 4)) >> 1; }
        else { const int sub = ob >> 9, e = (ob & 511) >> 1, kk = (sub >> 2) * 8 + (e >> 5), k = (kk & ~0xC) | ((kk & 4) << 1) | ((kk & 8) >> 1); key = (region & 1) * 64 + k; col = 256 + (sub & 3) * 32 + (e & 31); }
        doff[q] = (unsigned)(key * INW + col) * 2u; }
    const int nlat_u = (1024 - C.bid + C.G - 1) / C.G, nctx_u = (do_ctx && C.bid >= C.G - 16) ? 1 : 0;
#pragma unroll 1
    for (int ui = 0; ui < nlat_u + nctx_u; ++ui) {
        const int unit = ui < nlat_u ? 16 + C.bid + C.G * ui : C.G - 1 - C.bid;
        bool isctx; int b, qb, kvh, hp;
        if (unit < 16) { isctx = true; b = unit >> 3; kvh = (unit >> 2) & 1; hp = (unit >> 1) & 1; qb = unit & 1; }
        else { const int u = unit - 16; isctx = false; hp = u & 1; kvh = (u >> 1) & 1; qb = (u >> 2) & 127; b = u >> 9; }
        const int hq = kvh * 4 + hp * 2 + (wid >> 2), t = qb * 128 + (wid & 3) * 32 + r32;
        const size_t seqrow0 = isctx ? (size_t)(NLAT + b * CTXL) : (size_t)b * SEQ;
        const size_t ctxrow0 = (size_t)(NLAT + b * CTXL);
        const int blo = isctx ? 0 : (qb == 0 ? 1 : 0), bhi = isctx ? 0 : (qb == SEQ / 128 - 1 ? 2 : 3), nband = bhi - blo, nst = nband + 2;
#define ATT_BASE(i) ((const char*)(PX + ((i) < nband ? seqrow0 + (size_t)(128 * (qb - 1 + blo + (i))) : ctxrow0 + (size_t)(128 * ((i) - nband))) * INW + Q_END + kvh * 128))
#define ATT_DMA(i) do { const char* gb_ = ATT_BASE(i); LAS unsigned char* lb_ = C.lds + ((i) & 1) * 65536 + wid * 1024; \
        _Pragma("unroll") for (int q_ = 0; q_ < 8; ++q_) __builtin_amdgcn_global_load_lds((const unsigned*)(gb_ + doff[q_]), (LAS unsigned*)(lb_ + q_ * 8192), 16, 0, 0); } while (0)
        __syncthreads();
        ATT_DMA(0);
        bf16x8 qr[8];
        { const bf16* qp = PX + (seqrow0 + t) * INW + hq * 128 + hi * 8;
#pragma unroll
          for (int d0 = 0; d0 < 8; ++d0) qr[d0] = *(const bf16x8*)(qp + d0 * 16);
          if (!isctx) {
#pragma unroll
            for (int hf = 0; hf < 2; ++hf) { const int pos = hf ? (t & 63) : (t >> 6);
#pragma unroll
                for (int dd = 0; dd < 2; ++dd) { const int d0 = hf * 4 + dd; const cf32* rt = ROPE + pos * 32 + dd * 16 + hi * 8; bf16x8 a = qr[d0], bq = qr[d0 + 2];
#pragma unroll
                    for (int j = 0; j < 8; ++j) { const float x1 = bf2f((unsigned short)a[j]), x2 = bf2f((unsigned short)bq[j]); const cf32 cs = rt[j];
                        a[j] = (short)f2bf(x1 * cs.x - x2 * cs.y); bq[j] = (short)f2bf(x2 * cs.x + x1 * cs.y); }
                    qr[d0] = a; qr[d0 + 2] = bq; } } } }
        float m_reg = PIN(I_SINK)[l * 8 + hq] * (1.0f / SCALE), l_reg = 1.f; f32x16 o[4] = {};
#pragma unroll 1
        for (int i = 0; i < nst; ++i) {
            char* buf = LB + (i & 1) * 65536;
            asm volatile("s_waitcnt vmcnt(0)" ::: "memory"); __syncthreads();
            if (i + 1 < nst) ATT_DMA(i + 1);
            const int blk = blo + i; const bool masked = (i < nband) && (blk != 1);
#pragma unroll 1
            for (int hh = 0; hh < 2; ++hh) {
                const int s0 = 128 * (qb - 1 + blk) + 64 * hh;
                if (masked && ((blk == 0 && hh == 0 && (wid & 3) >= 2) || (blk == 2 && hh == 1 && (wid & 3) < 2))) continue;
                f32x16 p0, p1; qkt(p0, p1, buf + 32768 + hh * 16384, qr, r32, hi);
                if (masked) {
                    const bool prev = (blk == 0); const int base = t - s0 - 4 * hi, u0 = prev ? base : -base;
#pragma unroll
                    for (int r = 0; r < 16; ++r) { const int cr = (r & 3) + 8 * (r >> 2); const int th0 = prev ? 128 + cr : 128 - cr, th1 = prev ? 160 + cr : 96 - cr;
                        if (u0 > th0) p0[r] = -1e30f; if (u0 > th1) p1[r] = -1e30f; }
                }
                float mn, alpha; partialSM(p0, p1, m_reg, mn, alpha);
                if (__any(alpha < 1.f)) { if (hi == 0) al_l[r32] = alpha; asm volatile("s_waitcnt lgkmcnt(0)" ::: "memory");
#pragma unroll
                    for (int d = 0; d < 4; ++d)
#pragma unroll
                        for (int r = 0; r < 16; ++r) o[d][r] *= al_l[crow(r, hi)]; }
                bf16x8 pa0, pa1, pa2, pa3; finishSM(p0, p1, alpha, l_reg, pa0, pa1, pa2, pa3); SBAR();
                pv_d0(o, vbase + (i & 1) * 65536 + hh * 16384, pa0, pa1, pa2, pa3);
            }
        }
#undef ATT_BASE
#undef ATT_DMA
        if (hi == 0) li_l[r32] = l_reg; asm volatile("s_waitcnt lgkmcnt(0)" ::: "memory");
        { char* tb = LB + (nst & 1) * 65536 + wid * 8192;
#pragma unroll
          for (int r = 0; r < 16; ++r) { const int orow = crow(r, hi); const float rl = __builtin_amdgcn_rcpf(li_l[orow]);
#pragma unroll
              for (int d0 = 0; d0 < 4; ++d0) *(bf16*)(tb + orow * 256 + (d0 * 32 + r32) * 2) = (bf16)f2bf(o[d0][r] * rl); }
          asm volatile("s_waitcnt lgkmcnt(0)" ::: "memory");
          bf16* Ow = MG + (seqrow0 + qb * 128 + (wid & 3) * 32) * DM + hq * 128;
#pragma unroll
          for (int k = 0; k < 8; ++k) { const int q = lane + 64 * k, row = q >> 4, ch = q & 15;
              *(u32x4*)(Ow + (size_t)row * DM + ch * 8) = *(const u32x4*)(tb + row * 256 + ch * 16); } }
    }
    __syncthreads();
}

__device__ __forceinline__ void ph_mix_post(const Ctx& C, const Args& A, int l, bool do_attn, int nrows) {
    LAS float* ytile = (LAS float*)C.lds;
    LAS float* vtile = ytile + 32 * 516;
    const bf16* PX = WSA(bf16, WS_PX); bf16* MG = WSA(bf16, WS_MERGED); const bf16* PR = WSA(bf16, WS_PORAW); const bf16* VT = WSA(bf16, WS_VT); const float* YT = WSA(float, WS_YT);
    const float* cw = PIN(I_HCW) + l * 3 * 1536; const float* cb = PIN(I_HCB) + l * 1536; const float* hbias = PIN(I_HBIAS) + l * 512; const float* psc = PIN(I_POOLS) + l * 512; const float* gbr = PIN(I_GBRANCH) + l * DM;
    const int c0 = C.lane * 8;
    float r_cb[8], r_cw[3][8], r_hb[8], r_gh[8], r_ps[8], r_gp[8], r_ga[16];
#pragma unroll
    for (int i = 0; i < 8; ++i) { r_cb[i] = cb[c0 + i]; r_hb[i] = hbias[c0 + i]; r_gh[i] = gbr[1024 + c0 + i]; r_ps[i] = psc[c0 + i]; r_gp[i] = gbr[1536 + c0 + i];
        r_cw[0][i] = cw[c0 + i]; r_cw[1][i] = cw[1536 + c0 + i]; r_cw[2][i] = cw[3072 + c0 + i]; }
#pragma unroll
    for (int i = 0; i < 16; ++i) r_ga[i] = gbr[C.lane * 16 + i];
    for (int it = C.bid; it < nrows / 32; it += C.G) {
        const int r0 = it * 32; int seq0, seqlen; seq_of_row(r0, seq0, seqlen);
#pragma unroll
        for (int k = 0; k < 8; ++k) { const int c = (C.tid >> 3) + 64 * k, t4 = (C.tid & 7) * 4; const f32x4 y = *(const f32x4*)(YT + (size_t)c * MROWS + r0 + t4);
            ytile[(t4 + 0) * 516 + c] = y.x; ytile[(t4 + 1) * 516 + c] = y.y; ytile[(t4 + 2) * 516 + c] = y.z; ytile[(t4 + 3) * 516 + c] = y.w; }
#pragma unroll
        for (int k = 0; k < 4; ++k) { const int c = (C.tid >> 2) + 128 * k, t8 = (C.tid & 3) * 8; const u32x4 v = *(const u32x4*)(VT + (size_t)c * MROWS + r0 + t8);
#pragma unroll
            for (int i = 0; i < 8; ++i) vtile[(t8 + i) * 516 + c] = bfv(v, i); }
        __syncthreads();
#pragma unroll 1
        for (int q = 0; q < 4; ++q) {
            const int tt = C.wave * 4 + q, r = r0 + tt, tin = r - seq0;
            { float x0[8], hy[8];
#pragma unroll
              for (int i = 0; i < 8; ++i) x0[i] = r_cb[i];
#pragma unroll
              for (int dt = -1; dt <= 1; ++dt) { if (tin + dt < 0 || tin + dt >= seqlen) continue;
                  const u32x4 a = *(const u32x4*)(PX + (size_t)(r + dt) * INW + V_END + c0);
#pragma unroll
                  for (int i = 0; i < 8; ++i) x0[i] += bfv(a, i) * r_cw[dt + 1][i]; }
              const f32x4 ya = *(const LAS f32x4*)(ytile + tt * 516 + c0), yb = *(const LAS f32x4*)(ytile + tt * 516 + c0 + 4);
              const f32x4 va = *(const LAS f32x4*)(vtile + tt * 516 + c0), vb = *(const LAS f32x4*)(vtile + tt * 516 + c0 + 4);
              float ss = 0.f;
#pragma unroll
              for (int i = 0; i < 8; ++i) { const float y = i < 4 ? ya[i] : yb[i - 4], v = i < 4 ? va[i] : vb[i - 4]; hy[i] = (y + v * r_hb[i]) * x0[i]; ss += hy[i] * hy[i]; }
              const float rstd = rsqrtf(wave_sum(ss) * (1.f / HYW) + EPS); const float* g = r_gh;
              u32x4 w; w.x = pk2(hy[0] * rstd * g[0], hy[1] * rstd * g[1]); w.y = pk2(hy[2] * rstd * g[2], hy[3] * rstd * g[3]);
              w.z = pk2(hy[4] * rstd * g[4], hy[5] * rstd * g[5]); w.w = pk2(hy[6] * rstd * g[6], hy[7] * rstd * g[7]);
              *(u32x4*)(MG + (size_t)r * DM + 1024 + c0) = w; }
            { const u32x4 a = *(const u32x4*)(PR + (size_t)r * 512 + c0); float po[8]; float ss = 0.f;
#pragma unroll
              for (int i = 0; i < 8; ++i) { po[i] = bfv(a, i) * r_ps[i]; ss += po[i] * po[i]; }
              const float rstd = rsqrtf(wave_sum(ss) * (1.f / PLW) + EPS); const float* g = r_gp;
              u32x4 w; w.x = pk2(po[0] * rstd * g[0], po[1] * rstd * g[1]); w.y = pk2(po[2] * rstd * g[2], po[3] * rstd * g[3]);
              w.z = pk2(po[4] * rstd * g[4], po[5] * rstd * g[5]); w.w = pk2(po[6] * rstd * g[6], po[7] * rstd * g[7]);
              *(u32x4*)(MG + (size_t)r * DM + 1536 + c0) = w; }
            if (do_attn) { bf16* ap = MG + (size_t)r * DM + C.lane * 16; const u32x4 a = *(const u32x4*)ap, b = *(const u32x4*)(ap + 8); float av[16]; float ss = 0.f;
#pragma unroll
              for (int i = 0; i < 8; ++i) { av[i] = bfv(a, i); av[8 + i] = bfv(b, i); }
#pragma unroll
              for (int i = 0; i < 16; ++i) ss += av[i] * av[i];
              const float rstd = rsqrtf(wave_sum(ss) * (1.f / 1024.f) + EPS); const float* g = r_ga;
              u32x4 w0, w1; w0.x = pk2(av[0] * rstd * g[0], av[1] * rstd * g[1]); w0.y = pk2(av[2] * rstd * g[2], av[3] * rstd * g[3]);
              w0.z = pk2(av[4] * rstd * g[4], av[5] * rstd * g[5]); w0.w = pk2(av[6] * rstd * g[6], av[7] * rstd * g[7]);
              w1.x = pk2(av[8] * rstd * g[8], av[9] * rstd * g[9]); w1.y = pk2(av[10] * rstd * g[10], av[11] * rstd * g[11]);
              w1.z = pk2(av[12] * rstd * g[12], av[13] * rstd * g[13]); w1.w = pk2(av[14] * rstd * g[14], av[15] * rstd * g[15]);
              *(u32x4*)ap = w0; *(u32x4*)(ap + 8) = w1; }
        }
        __syncthreads();
    }
}
constexpr int NPHASES = 2 + 10 + 9 * (DEPTH - 1);
__device__ __forceinline__ Ctx fresh(const Ctx& C) { Ctx R = C; R.tid = fft_launder(C.tid); R.lane = R.tid & 63; return R; }
#define CL fresh(C)
#ifndef PROBE_GEMM
#define PROBE_GEMM 0
#endif
#ifndef PROBE_FFT
#define PROBE_FFT 0
#endif
#ifndef PROBE_MLP
#define PROBE_MLP 0
#endif
#ifndef PROBE_FFTF
#define PROBE_FFTF 0
#endif
#if PROBE_MLP
#define MLP_REP(...) __VA_ARGS__ __VA_ARGS__
#else
#define MLP_REP(...) __VA_ARGS__
#endif
#if PROBE_FFTF
#define FFTF_REP(...) __VA_ARGS__ __VA_ARGS__
#else
#define FFTF_REP(...) __VA_ARGS__
#endif
#ifndef PROBE_MP
#define PROBE_MP 0
#endif
#ifndef PROBE_RN
#define PROBE_RN 0
#endif
#if PROBE_MP
#define MP_REP(...) __VA_ARGS__
#else
#define MP_REP(...)
#endif
#if PROBE_RN
#define RN_REP(...) __VA_ARGS__
#else
#define RN_REP(...)
#endif
#ifndef WGM_DOWN
#define WGM_DOWN 4
#endif
#ifndef WGM_IN
#define WGM_IN 4
#endif
#ifndef WGM_OUT
#define WGM_OUT 4
#endif
#ifndef WGM_UP
#define WGM_UP 4
#endif
#ifndef PROBE_WIN
#define PROBE_WIN 0
#endif
#ifndef PROBE_GD0
#define PROBE_GD0 0
#endif
#ifndef PROBE_GU
#define PROBE_GU 0
#endif
#ifndef PROBE_GD
#define PROBE_GD 0
#endif
#if PROBE_GU || PROBE_GEMM
#define GEMMU_REP(...) __VA_ARGS__ __syncthreads(); __VA_ARGS__
#else
#define GEMMU_REP(...) __VA_ARGS__
#endif
#if PROBE_GD || PROBE_GEMM
#define GEMMD_REP(...) __VA_ARGS__ __syncthreads(); __VA_ARGS__
#else
#define GEMMD_REP(...) __VA_ARGS__
#endif
#ifndef PROBE_ATT
#define PROBE_ATT 0
#endif
#ifndef PROBE_PRE
#define PROBE_PRE 0
#endif
#if PROBE_GEMM
#define GEMM_REP(...) __VA_ARGS__ __syncthreads(); __VA_ARGS__
#else
#define GEMM_REP(...) __VA_ARGS__
#endif
#if PROBE_FFT
#define FFT_REP(...) __VA_ARGS__ __VA_ARGS__
#else
#define FFT_REP(...) __VA_ARGS__
#endif
#if PROBE_ATT
#define ATT_REP(...) __VA_ARGS__ __VA_ARGS__
#else
#define ATT_REP(...) __VA_ARGS__
#endif
#if PROBE_PRE
#define PRE_REP(...) __VA_ARGS__ __VA_ARGS__
#else
#define PRE_REP(...) __VA_ARGS__
#endif
#ifndef TPROBE
#define TPROBE 0
#endif
#ifndef MIX_SWAP
#define MIX_SWAP 0
#endif
#if TPROBE
#define TP_TS ((unsigned long long*)(A.ws + WS_CTL + 131072))
#define TP_MK ((unsigned long long*)(A.ws + WS_CTL + 262144))
#define TP_MARK(id, k) if (C.tid == 0) TP_MK[((id) * 4 + (k)) * 256 + C.bid] = __builtin_amdgcn_s_memrealtime();
#define TP_KIND(p) ((p) < 3 ? (p) : 3 + ((p) - 3) % 9)
#ifndef TP_SEL
#define TP_SEL(p) 1
#endif
#ifndef TP_MODE
#define TP_MODE 1
#endif
#ifndef TP_SCALE
#define TP_SCALE 4
#endif
#ifndef TP_K0
#define TP_K0 0
#define TP_K1 1
#endif
#else
#define TP_MARK(id, k)
#endif
__global__ void __launch_bounds__(512, 2) trunk_fwd(Args A) {
    extern __shared__ __attribute__((aligned(16))) unsigned char lds_raw[];
    Ctx C;
    C.lds = (LAS unsigned char*)lds_raw; C.ldsg = (char*)lds_raw;
    C.tid = threadIdx.x; C.lane = C.tid & 63; C.wave = __builtin_amdgcn_readfirstlane(C.tid >> 6); C.bid = blockIdx.x; C.G = gridDim.x;
    volatile LAS unsigned* MISC = (volatile LAS unsigned*)(C.lds + LDS_MISC);
    if (C.tid < 64) MISC[C.tid] = 0u;
    __syncthreads();
    unsigned* barw = (unsigned*)(A.ws + WS_CTL) + 4096;
    XcdBarrier bar; bar.bar = barw; bar.x = 0; bar.st = nullptr;
#if !MK_PER_PHASE
    bar = xcd_barrier_post(barw, MISC);
#endif
    const int lo = A.ph_lo, hi = A.ph_hi;
#if MK_PER_PHASE
#define PH_END(id) }
#elif TPROBE
#define PH_END(id) if (C.tid == 0) TP_TS[((id) + 1) * 256 + C.bid] = __builtin_amdgcn_s_memrealtime(); xcd_barrier(bar); }
#else
#define PH_END(id) if ((id) + 1 < hi) xcd_barrier(bar); }
#endif
#if TPROBE
    if (C.tid == 0) TP_TS[C.bid] = __builtin_amdgcn_s_memrealtime();
#endif
#define PH_BEGIN(id) if (lo <= (id) && (id) < hi) {
    const float* MOD = WSA(float, WS_MOD);
    PH_BEGIN(0) ph_pro_a(CL, A); PH_END(0)
    PH_BEGIN(1) ph_pro_b(CL, A); PH_END(1)
    int id = 2;
#pragma unroll 1
    for (int l = 0; l < DEPTH; ++l) {
        const float* modl = MOD + (size_t)l * 3 * MODW; const bool last = (l == DEPTH - 1); const int mrows = last ? NLAT : MROWS;
        unsigned char* wl = A.ws + WS_WT + (size_t)l * WT_LAYER;
        if (l == 0) {
            PH_BEGIN(id) MLP_REP(ph_filter_mlp(CL, A, 0);)
                ph_rownorm<true, false>(CL, A, false, nullptr, nullptr, true, PIN(I_GPREMIX), modl + 0 * DM, modl + 1 * DM, MROWS, 0); PH_END(id)
            ++id;
        }
        PH_BEGIN(id)
#if PROBE_WIN
            { pg8::Gemm g{WSA(bf16, WS_HX), (const bf16*)(wl + WT_IN), PROBE_WIN, INW, DM, DM, 0, 1}; pg8::RevOrder S; S.init(PROBE_WIN, INW, C.G, C.bid, WGM_IN);
              pg8::EpiOut<0> E{WSA(bf16, WS_PX), INW, 0}; pg8::gemm_phase<pg8::EpiOut<0>, pg8::RevOrder, true, true>(C.lds, g, S, E); } __syncthreads();
#endif
            GEMM_REP({ pg8::Gemm g{WSA(bf16, WS_HX), (const bf16*)(wl + WT_IN), MROWS, INW, DM, DM, 0, 1}; pg8::RevOrder S; S.init(MROWS, INW, C.G, C.bid, WGM_IN);
            pg8::EpiOut<0> E{WSA(bf16, WS_PX), INW, 0}; pg8::gemm_phase<pg8::EpiOut<0>, pg8::RevOrder, true, true>(C.lds, g, S, E); })
            FFTF_REP(ph_filter_fft(CL, A, ((MROWS / 256) * (INW / 256)) % C.G, 2);) PH_END(id)
        ++id;
        PH_BEGIN(id) ph_krope(CL, A); PRE_REP(ph_hyena_pre(CL, A, l, mrows); ph_pool_pre(CL, A, mrows);) PH_END(id)
        ++id;
        PH_BEGIN(id) TP_MARK(id, 0)
#if MIX_SWAP
#pragma unroll 1
            for (int st = 0; st < 2; ++st) { if ((((C.bid >> 3) ^ st) & 1) == 0) { ph_conv<0>(CL, A); if (!last) ph_conv_ctx(CL, A); } else ph_attention(CL, A, l, !last); }
#else
            FFT_REP(ph_conv<0>(CL, A); if (!last) ph_conv_ctx(CL, A);) TP_MARK(id, 1) ATT_REP(ph_attention(CL, A, l, !last);) TP_MARK(id, 2)
#endif
            GEMM_REP({ pg8::Gemm g{WSA(bf16, WS_POOLED), (const bf16*)(wl + WT_POOL), mrows, 512, 512, 512, 0, 1}; pg8::StaticOrder S; S.init(mrows, 512, C.G, C.bid);
              pg8::EpiOut<0> E{WSA(bf16, WS_PORAW), 512, 0}; pg8::gemm_phase<pg8::EpiOut<0>, pg8::StaticOrder, true, true>(C.lds, g, S, E); }) TP_MARK(id, 3) PH_END(id)
        ++id;
        PH_BEGIN(id) MP_REP(ph_mix_post(CL, A, l, false, mrows);) ph_mix_post(CL, A, l, true, mrows); PH_END(id)
        ++id;
        PH_BEGIN(id) GEMM_REP({ pg8::Gemm g{WSA(bf16, WS_MERGED), (const bf16*)(wl + WT_OUT), NLAT, DM, DM, DM, 0, 1}; pg8::RevOrder S; S.init(NLAT, DM, C.G, C.bid, WGM_OUT);
            pg8::EpiOut<0> E{WSA(bf16, WS_OX), DM, 0}; pg8::gemm_phase<pg8::EpiOut<0>, pg8::RevOrder, true, true>(C.lds, g, S, E); })
            if (!last) { pg8::Gemm g{WSA(bf16, WS_MERGED) + (size_t)NLAT * DM, (const bf16*)(wl + WT_OUT), NCTX, DM, 256, DM, 0, 1}; pg8::SplitOrder S; S.init(NCTX, DM, 8, 256, C.G, C.bid);
                pg8::EpiPart E{WSA(float, WS_PART), DM, (size_t)NCTX * DM}; pg8::gemm_phase<pg8::EpiPart, pg8::SplitOrder, true, true>(C.lds, g, S, E); } PH_END(id)
        ++id;
        PH_BEGIN(id)
            if (l == 0) ph_rownorm<true, false>(CL, A, true, PIN(I_GPOSTMIX) + l * DM, modl + 2 * DM, true, PIN(I_GPREMLP) + l * DM, modl + 3 * DM, modl + 4 * DM, mrows, 8);
            else ph_rownorm<false, false>(CL, A, true, PIN(I_GPOSTMIX) + l * DM, modl + 2 * DM, true, PIN(I_GPREMLP) + l * DM, modl + 3 * DM, modl + 4 * DM, mrows, 8);
        PH_END(id)
        ++id;
        PH_BEGIN(id) GEMMU_REP({ pg8::Gemm g{WSA(bf16, WS_HX), (const bf16*)(wl + WT_UP), mrows, MLPH, DM, DM, 0, 1}; pg8::RevOrder S; S.init(mrows, MLPH, C.G, C.bid, WGM_UP);
            pg8::EpiOut<1> E{WSA(bf16, WS_H), MLPH, 1}; pg8::gemm_phase<pg8::EpiOut<1>, pg8::RevOrder, true, true>(C.lds, g, S, E); }) PH_END(id)
        ++id;
        PH_BEGIN(id)
#if PROBE_GD0
            { pg8::Gemm g{WSA(bf16, WS_H), (const bf16*)(wl + WT_DOWN), NLAT, DM, MLPH, MLPH, 1, 1}; pg8::FakeOrder S; S.init(NLAT, DM, C.G, C.bid);
              pg8::EpiOut<0> E{WSA(bf16, WS_OX), DM, 0}; pg8::gemm_phase<pg8::EpiOut<0>, pg8::FakeOrder, true, true>(C.lds, g, S, E); } __syncthreads();
#endif
            GEMMD_REP({ pg8::Gemm g{WSA(bf16, WS_H), (const bf16*)(wl + WT_DOWN), NLAT, DM, MLPH, MLPH, 1, 1}; pg8::StaticOrder S; S.init(NLAT, DM, C.G, C.bid, WGM_DOWN);
            pg8::EpiOut<0> E{WSA(bf16, WS_OX), DM, 0}; pg8::gemm_phase<pg8::EpiOut<0>, pg8::StaticOrder, true, true>(C.lds, g, S, E); })
            if (!last) { pg8::Gemm g{WSA(bf16, WS_H) + (size_t)NLAT * MLPH, (const bf16*)(wl + WT_DOWN), NCTX, DM, 512, MLPH, 1, 1}; pg8::SplitOrder S; S.init(NCTX, DM, 16, 512, C.G, C.bid);
                pg8::EpiPart E{WSA(float, WS_PART), DM, (size_t)NCTX * DM}; pg8::gemm_phase<pg8::EpiPart, pg8::SplitOrder, true, true>(C.lds, g, S, E); } PH_END(id)
        ++id;
        PH_BEGIN(id)
            if (l + 1 < DEPTH) { const float* modn = modl + 3 * MODW;
                ph_rownorm<false, false>(CL, A, true, PIN(I_GPOSTMLP) + l * DM, modl + 5 * DM, true, PIN(I_GPREMIX) + (l + 1) * DM, modn + 0 * DM, modn + 1 * DM, MROWS, 16);
                MLP_REP(ph_filter_mlp(CL, A, l + 1);) }
            else ph_rownorm<false, true>(CL, A, true, PIN(I_GPOSTMLP) + l * DM, modl + 5 * DM, false, nullptr, nullptr, nullptr, NLAT, 0);
        PH_END(id)
        ++id;
    }
#undef PH_BEGIN
#undef PH_END
#if TPROBE
    if (C.bid == 0 && C.wave == 0) {
        const volatile unsigned long long* ts = TP_TS;
        const unsigned long long t0 = ts[0];
        float metric = 0.f, prevmax = 0.f;
#pragma unroll 1
        for (int p = 0; p <= NPHASES; ++p) {
            float mx = -1e30f, sm = 0.f;
            for (int k = 0; k < 4; ++k) { const float v = (float)(long long)(ts[p * 256 + C.lane + 64 * k] - t0); mx = fmaxf(mx, v); sm += v; }
            for (int o = 32; o; o >>= 1) { mx = fmaxf(mx, __shfl_xor(mx, o)); sm += __shfl_xor(sm, o); }
            if (TP_MODE == 2) { if (p > 0 && (TP_SEL((p - 1)))) { float dm = 0.f;
                    for (int k = 0; k < 4; ++k) dm += (float)(long long)(TP_MK[((p - 1) * 4 + TP_K1) * 256 + C.lane + 64 * k] - TP_MK[((p - 1) * 4 + TP_K0) * 256 + C.lane + 64 * k]);
                    for (int o = 32; o; o >>= 1) dm += __shfl_xor(dm, o);
                    metric += dm * (1.f / 256.f); } }
            else
            if (p > 0 && (TP_SEL((p - 1)))) metric += TP_MODE ? (mx - sm * (1.f / 256.f)) : (mx - prevmax);
            prevmax = mx;
        }
        const unsigned long long spin = (unsigned long long)(metric * TP_SCALE), tb = __builtin_amdgcn_s_memrealtime();
        while (__builtin_amdgcn_s_memrealtime() - tb < spin) __builtin_amdgcn_s_sleep(8);
    }
#endif
}

extern "C" void kernel_launch(void* const* d_in, const int* in_sizes, int n_in, void* d_out, int out_size, void* d_ws, size_t ws_size, hipStream_t stream) {
    static int grid = 0;
    if (grid == 0) {
        if (n_in != NIN || in_sizes[0] != NLAT * DM || out_size != NLAT * DM || ws_size < WS_END) {
            fprintf(stderr, "kernel_launch: shape mismatch: n_in %d in0 %d out %d ws %zu (need %zu); nothing launched\n", n_in, n_in > 0 ? in_sizes[0] : -1, out_size, ws_size, (size_t)WS_END); grid = -1; return; }
        int dev = 0, cus = 0, per_cu = 0;
        if (hipGetDevice(&dev) != hipSuccess || hipDeviceGetAttribute(&cus, hipDeviceAttributeMultiprocessorCount, dev) != hipSuccess) { fprintf(stderr, "kernel_launch: device query failed\n"); grid = -1; return; }
        if (hipFuncSetAttribute((const void*)trunk_fwd, hipFuncAttributeMaxDynamicSharedMemorySize, LDS_BYTES) != hipSuccess) { fprintf(stderr, "kernel_launch: hipFuncSetAttribute failed\n"); grid = -1; return; }
        if (hipOccupancyMaxActiveBlocksPerMultiprocessor(&per_cu, (const void*)trunk_fwd, 512, LDS_BYTES) != hipSuccess || per_cu < 1)
            fprintf(stderr, "kernel_launch: note: occupancy query reports %d workgroups per CU\n", per_cu);
        (void)hipGetLastError();
        grid = (cus < 256 ? cus : 256) & ~7;
    }
    if (grid < 0) return;
    if (hipMemsetAsync((char*)d_ws + WS_CTL, 0, CTL_ZERO_BYTES, stream) != hipSuccess) { fprintf(stderr, "kernel_launch: memset failed\n"); return; }
    Args a{};
    for (int i = 0; i < NIN; ++i) a.in[i] = (const float*)d_in[i];
    a.out = (float*)d_out; a.ws = (unsigned char*)d_ws;
#if MK_PER_PHASE
    for (int ph = 0; ph < NPHASES; ++ph) { a.ph_lo = ph; a.ph_hi = ph + 1;
        hipLaunchKernelGGL(trunk_fwd, dim3(grid), dim3(512), LDS_BYTES, stream, a); }
#else
    a.ph_lo = 0; a.ph_hi = NPHASES;
    hipLaunchKernelGGL(trunk_fwd, dim3(grid), dim3(512), LDS_BYTES, stream, a);
#endif
    const hipError_t le = hipPeekAtLastError();
    if (le != hipSuccess) fprintf(stderr, "kernel_launch: launch failed: %s\n", hipGetErrorName(le));
}
```
